# Optimizing an MI355X kernel written in HIP

```python
import math
import jax, jax.numpy as jnp
from jax import lax
import numpy as np

D_MODEL = 1024
BATCH = 16
SEQ = 2048
DEPTH = 2

PLE_DIM = 256
ROPE_THETA = 500000.0
MAX_POS_OFFSET = 4096
A_HEAD_DIM = 64
A_HEADS = D_MODEL // (2 * A_HEAD_DIM)
A_ROT = A_HEAD_DIM // 4
A_PATTERNS = ((128, 1), (512, 4), (2048, 16))
B_HEADS = D_MODEL // 128
B_Q_LORA = 3 * D_MODEL // 8
B_KV_LORA = D_MODEL // 4
B_NOPE = 64
B_ROPE = 32
B_V = 64
C_HEAD_DIM = 64
C_HEADS = D_MODEL // (2 * C_HEAD_DIM)
C_ROT = C_HEAD_DIM // 4
D_FF = 256 * math.ceil(8 * D_MODEL / 3 / 256)
CONV_WIDTH = 3
Q_BLOCK = 128
LN_EPS = 1e-5
RMS_EPS = 1e-6
NEG_INF = -1e30
N_AB = (DEPTH + 1) // 2
N_C = DEPTH // 2
ALPHA = (2 * DEPTH) ** 0.25
BETA = (8 * DEPTH) ** -0.25
A_WIDTH = A_HEADS * A_HEAD_DIM
AB_IN = 3 * A_WIDTH + B_Q_LORA + B_KV_LORA + B_ROPE
AB_MIX = A_WIDTH + B_HEADS * B_V
C_QK = C_HEADS * 2 * C_HEAD_DIM
C_MIX = C_HEADS * 2 * C_HEAD_DIM

kernel_name = "hybrid_dilated_mla_diff_encoder"


def layer_norm(x, g, b):
    xf = x.astype(jnp.float32)
    mu = jnp.mean(xf, axis=-1, keepdims=True)
    var = jnp.mean(jnp.square(xf - mu), axis=-1, keepdims=True)
    y = (xf - mu) * lax.rsqrt(var + LN_EPS)
    return (y * g.astype(jnp.float32) + b.astype(jnp.float32)).astype(x.dtype)


def rms_norm(x, g, eps):
    xf = x.astype(jnp.float32)
    y = xf * lax.rsqrt(jnp.mean(jnp.square(xf), axis=-1, keepdims=True) + eps)
    return (y * g.astype(jnp.float32)).astype(x.dtype)


def rope_tables(positions, rot):
    inv_freq = 1.0 / (ROPE_THETA ** (jnp.arange(0, rot, 2, dtype=jnp.float32) / rot))
    ang = positions.astype(jnp.float32)[..., None] * inv_freq
    return jnp.cos(ang), jnp.sin(ang)


def apply_rope(x, cos, sin, rot):
    bshape = cos.shape[:2] + (1,) * (x.ndim - 3) + cos.shape[-1:]
    c = cos.reshape(bshape).astype(x.dtype)
    s = sin.reshape(bshape).astype(x.dtype)
    half = rot // 2
    x1, x2, rest = x[..., :half], x[..., half:rot], x[..., rot:]
    return jnp.concatenate([x1 * c - x2 * s, x2 * c + x1 * s, rest], axis=-1)


def dilated_window_attention(q, k, v, window, dilation):
    B, H, S, dh = q.shape
    n_side = window // (2 * dilation)
    L = S // dilation
    blk = n_side
    nb = -(-L // blk)
    Lp = nb * blk

    def strided(t):
        return t.reshape(B, H, L, dilation, dh).transpose(0, 1, 3, 2, 4)

    def slabs(t):
        tp = jnp.pad(t, ((0, 0), (0, 0), (0, 0), (blk, Lp - L + blk), (0, 0)))
        tp = tp.reshape(B, H, dilation, nb + 2, blk, dh)
        return jnp.concatenate([tp[:, :, :, 0:nb], tp[:, :, :, 1:nb + 1], tp[:, :, :, 2:nb + 2]], axis=4)

    qb = jnp.pad(strided(q), ((0, 0), (0, 0), (0, 0), (0, Lp - L), (0, 0))).reshape(B, H, dilation, nb, blk, dh)
    kb = slabs(strided(k))
    vb = slabs(strided(v))
    s = jnp.einsum("bhrnqd,bhrnkd->bhrnqk", qb, kb) * (dh ** -0.5)
    qi = jnp.arange(nb)[:, None, None] * blk + jnp.arange(blk)[None, :, None]
    ki = jnp.arange(nb)[:, None, None] * blk - blk + jnp.arange(3 * blk)[None, None, :]
    valid = (ki >= 0) & (ki < L) & (jnp.abs(ki - qi) <= n_side)
    s = jnp.where(valid, s, NEG_INF)
    m = jnp.max(s, axis=-1, keepdims=True)
    e = jnp.exp(s - m)
    l = jnp.sum(e, axis=-1)
    o = jnp.einsum("bhrnqk,bhrnkd->bhrnqd", e, vb) / l[..., None]
    lse = m[..., 0] + jnp.log(l)
    o = o.reshape(B, H, dilation, Lp, dh)[:, :, :, :L].transpose(0, 1, 3, 2, 4).reshape(B, H, S, dh)
    lse = lse.reshape(B, H, dilation, Lp)[..., :L].transpose(0, 1, 3, 2).reshape(B, H, S)
    return o, lse


def dilated_mixture(q, k, v):
    B, S, H, dh = q.shape
    qf, kf, vf = (t.astype(jnp.float32).transpose(0, 2, 1, 3) for t in (q, k, v))
    outs, lses = [], []
    for window, dilation in A_PATTERNS:
        o, lse = dilated_window_attention(qf, kf, vf, window, dilation)
        outs.append(o)
        lses.append(lse)
    w = jax.nn.softmax(jnp.stack(lses), axis=0)
    o = jnp.sum(w[..., None] * jnp.stack(outs), axis=0)
    return o.transpose(0, 2, 1, 3).reshape(B, S, H * dh)


def dense_attention(q, k, v, scale):
    B, S, H, dq = q.shape
    dv = v.shape[-1]
    nq = S // Q_BLOCK
    kf = k.astype(jnp.float32).transpose(0, 2, 1, 3)
    vf = v.astype(jnp.float32).transpose(0, 2, 1, 3)
    qb = q.astype(jnp.float32).transpose(0, 2, 1, 3).reshape(B, H, nq, Q_BLOCK, dq).transpose(2, 0, 1, 3, 4)

    def block(qi):
        s = jnp.einsum("bhqd,bhkd->bhqk", qi, kf) * scale
        return jnp.einsum("bhqk,bhkd->bhqd", jax.nn.softmax(s, axis=-1), vf)

    o = lax.map(block, qb)
    return o.transpose(1, 0, 3, 2, 4).reshape(B, S, H * dv)


def diff_attention(q, k, v, lam):
    B, S, H, _, dh = q.shape
    dv = v.shape[-1]
    nq = S // Q_BLOCK
    kf = k.astype(jnp.float32).transpose(0, 2, 3, 1, 4)
    vf = v.astype(jnp.float32).transpose(0, 2, 1, 3)
    qb = q.astype(jnp.float32).transpose(0, 2, 3, 1, 4).reshape(B, H, 2, nq, Q_BLOCK, dh).transpose(3, 0, 1, 2, 4, 5)

    def block(qi):
        s = jnp.einsum("bhcqd,bhckd->bhcqk", qi, kf) * (dh ** -0.5)
        a = jax.nn.softmax(s, axis=-1)
        return jnp.einsum("bhqk,bhkd->bhqd", a[:, :, 0] - lam * a[:, :, 1], vf)

    o = lax.map(block, qb)
    return o.transpose(1, 0, 3, 2, 4).reshape(B, S, H, dv)


def mixer_ab(x, cos_a, sin_a, cos_b, sin_b, w_in, q_norm, w_q_up, kv_norm, w_kv_up, w_out):
    B, S, _ = x.shape
    h = x @ w_in
    o1 = A_WIDTH
    o2 = 2 * A_WIDTH
    o3 = 3 * A_WIDTH
    o4 = o3 + B_Q_LORA
    o5 = o4 + B_KV_LORA
    shape_a = (B, S, A_HEADS, A_HEAD_DIM)
    qa = apply_rope(h[..., :o1].reshape(shape_a), cos_a, sin_a, A_ROT)
    ka = apply_rope(h[..., o1:o2].reshape(shape_a), cos_a, sin_a, A_ROT)
    va = h[..., o2:o3].reshape(shape_a)
    out_a = dilated_mixture(qa, ka, va).astype(x.dtype)
    cq = rms_norm(h[..., o3:o4], q_norm, RMS_EPS)
    qb = (cq @ w_q_up).reshape(B, S, B_HEADS, B_NOPE + B_ROPE)
    q_pe = apply_rope(qb[..., B_NOPE:], cos_b, sin_b, B_ROPE)
    qb = jnp.concatenate([qb[..., :B_NOPE], q_pe], axis=-1)
    ckv = rms_norm(h[..., o4:o5], kv_norm, RMS_EPS)
    kv = (ckv @ w_kv_up).reshape(B, S, B_HEADS, B_NOPE + B_V)
    k_pe = apply_rope(h[..., o5:].reshape(B, S, 1, B_ROPE), cos_b, sin_b, B_ROPE)
    kb = jnp.concatenate([kv[..., :B_NOPE], jnp.broadcast_to(k_pe, (B, S, B_HEADS, B_ROPE))], axis=-1)
    vb = kv[..., B_NOPE:]
    out_b = dense_attention(qb, kb, vb, (B_NOPE + B_ROPE) ** -0.5).astype(x.dtype)
    return jnp.concatenate([out_a, out_b], axis=-1) @ w_out


def mixer_c(x, cos_c, sin_c, w_qkv, lam_params, subln, w_out, lambda_init):
    B, S, _ = x.shape
    h = x @ w_qkv
    q = apply_rope(h[..., :C_QK].reshape(B, S, C_HEADS, 2, C_HEAD_DIM), cos_c, sin_c, C_ROT)
    k = apply_rope(h[..., C_QK:2 * C_QK].reshape(B, S, C_HEADS, 2, C_HEAD_DIM), cos_c, sin_c, C_ROT)
    v = h[..., 2 * C_QK:].reshape(B, S, C_HEADS, 2 * C_HEAD_DIM)
    lp = lam_params.astype(jnp.float32)
    lam = jnp.exp(jnp.sum(lp[0] * lp[1])) - jnp.exp(jnp.sum(lp[2] * lp[3])) + lambda_init
    o = diff_attention(q, k, v, lam)
    o = rms_norm(o, subln, LN_EPS) * (1.0 - lambda_init)
    return o.reshape(B, S, C_MIX).astype(x.dtype) @ w_out


def conv_ffn(x, w_gate, w_up, conv_w, conv_b, w_down):
    S = x.shape[1]
    a = x @ w_gate
    u = x @ w_up
    pad = CONV_WIDTH // 2
    ap = jnp.pad(a, ((0, 0), (pad, pad), (0, 0)))
    c = conv_b
    for j in range(CONV_WIDTH):
        c = c + conv_w[j] * ap[:, j:j + S]
    return (jax.nn.gelu(c) * u) @ w_down


def setup_inputs(seed: int = 0) -> dict:
    key = jax.random.key(seed)
    ks = jax.random.split(key, 24)
    f32 = jnp.float32

    def w(k, shape, fan_in, gain=1.0):
        return jax.random.normal(k, shape, f32) * (gain * fan_in ** -0.5)

    def gain_init(k, shape):
        return 1.0 + 0.02 * jax.random.normal(k, shape, f32)

    def bias_init(k, shape):
        return 0.02 * jax.random.normal(k, shape, f32)

    x = jax.random.normal(ks[0], (BATCH, SEQ, D_MODEL), f32)
    p = jax.random.normal(ks[1], (DEPTH, BATCH, SEQ, PLE_DIM), f32)
    positions = (jnp.arange(SEQ, dtype=jnp.int32)[None, :]
                 + jax.random.randint(ks[2], (BATCH, 1), 0, MAX_POS_OFFSET, dtype=jnp.int32))
    return {
        "x": x,
        "p": p,
        "positions": positions,
        "ab_w_in": w(ks[3], (N_AB, D_MODEL, AB_IN), D_MODEL),
        "ab_q_norm": gain_init(ks[4], (N_AB, B_Q_LORA)),
        "ab_w_q_up": w(ks[5], (N_AB, B_Q_LORA, B_HEADS * (B_NOPE + B_ROPE)), B_Q_LORA),
        "ab_kv_norm": gain_init(ks[6], (N_AB, B_KV_LORA)),
        "ab_w_kv_up": w(ks[7], (N_AB, B_KV_LORA, B_HEADS * (B_NOPE + B_V)), B_KV_LORA),
        "ab_w_out": w(ks[8], (N_AB, AB_MIX, D_MODEL), AB_MIX, BETA),
        "c_w_qkv": w(ks[9], (N_C, D_MODEL, 2 * C_QK + C_MIX), D_MODEL),
        "c_lambda": 0.1 * jax.random.normal(ks[10], (N_C, 4, C_HEAD_DIM), f32),
        "c_subln": gain_init(ks[11], (N_C, 2 * C_HEAD_DIM)),
        "c_w_out": w(ks[12], (N_C, C_MIX, D_MODEL), C_MIX, BETA),
        "ln_mix_g": gain_init(ks[13], (DEPTH, D_MODEL)),
        "ln_mix_b": bias_init(ks[14], (DEPTH, D_MODEL)),
        "ffn_w_gate": w(ks[15], (DEPTH, D_MODEL, D_FF), D_MODEL),
        "ffn_w_up": w(ks[16], (DEPTH, D_MODEL, D_FF), D_MODEL),
        "ffn_conv_w": w(ks[17], (DEPTH, CONV_WIDTH, D_FF), CONV_WIDTH),
        "ffn_conv_b": bias_init(ks[18], (DEPTH, D_FF)),
        "ffn_w_down": w(ks[19], (DEPTH, D_FF, D_MODEL), D_FF, BETA),
        "ln_ffn_g": gain_init(ks[20], (DEPTH, D_MODEL)),
        "ln_ffn_b": bias_init(ks[21], (DEPTH, D_MODEL)),
        "ple_w_gate": w(ks[22], (DEPTH, D_MODEL, D_MODEL), D_MODEL),
        "ple_w_proj": w(ks[23], (DEPTH, PLE_DIM, D_MODEL), PLE_DIM),
    }


def reference(x, p, positions, ab_w_in, ab_q_norm, ab_w_q_up, ab_kv_norm, ab_w_kv_up, ab_w_out,
              c_w_qkv, c_lambda, c_subln, c_w_out, ln_mix_g, ln_mix_b, ffn_w_gate, ffn_w_up,
              ffn_conv_w, ffn_conv_b, ffn_w_down, ln_ffn_g, ln_ffn_b, ple_w_gate, ple_w_proj):
    cos_a, sin_a = rope_tables(positions, A_ROT)
    cos_b, sin_b = rope_tables(positions, B_ROPE)
    cos_c, sin_c = rope_tables(positions, C_ROT)
    for i in range(DEPTH):
        j = i // 2
        if i % 2 == 0:
            y = mixer_ab(x, cos_a, sin_a, cos_b, sin_b, ab_w_in[j], ab_q_norm[j], ab_w_q_up[j],
                         ab_kv_norm[j], ab_w_kv_up[j], ab_w_out[j])
        else:
            lambda_init = 0.8 - 0.6 * math.exp(-0.3 * i)
            y = mixer_c(x, cos_c, sin_c, c_w_qkv[j], c_lambda[j], c_subln[j], c_w_out[j], lambda_init)
        x = layer_norm(ALPHA * x + y, ln_mix_g[i], ln_mix_b[i])
        f = conv_ffn(x, ffn_w_gate[i], ffn_w_up[i], ffn_conv_w[i], ffn_conv_b[i], ffn_w_down[i])
        x = layer_norm(ALPHA * x + f, ln_ffn_g[i], ln_ffn_b[i])
        x = x + jax.nn.sigmoid(x @ ple_w_gate[i]) * (p[i] @ ple_w_proj[i])
    return x
```

```cpp
#include <hip/hip_runtime.h>
#include <hip/hip_cooperative_groups.h>
#include <cstdio>
#include <cstdint>
namespace cg = cooperative_groups;
namespace pg8 {
#define PG8_LAS __attribute__((address_space(3)))
typedef unsigned short bf16_t;
typedef short bf16x8 __attribute__((ext_vector_type(8)));
typedef float f32x4 __attribute__((ext_vector_type(4)));
typedef unsigned u32x4 __attribute__((ext_vector_type(4)));
constexpr int BM = 256, BK = 64, HALF = 128, HTB = HALF * BK * 2  , STAGE_BYTES = 8 * HTB, NXCD = 8, WGM = 8;

__host__ __device__ __forceinline__ int lds_byte(int r, int c) { const int st = (r >> 4) * 2 + (c >> 5), rr = r & 15, cc = c & 31, ob = rr * 64 + cc * 2; return st * 1024 + (ob ^ (((ob >> 9) & 1) << 5)); }
__host__ __device__ __forceinline__ void stage_rc(int b, int& R, int& C) { const int st = b / 1024, sb = b % 1024, swz = sb ^ (((sb >> 9) & 1) << 5); R = (st >> 1) * 16 + swz / 64; C = (st & 1) * 32 + (swz % 64) / 2; }
__host__ __device__ __forceinline__ int perm32(int rho) { const int n = rho >> 4, i = rho & 15; return 8 * (i >> 2) + 4 * n + (i & 3); }

struct Unit { int pm, pn; };
struct Gemm { const bf16_t* A; const bf16_t* Bt; int M, N, K; };

struct StaticOrder {
    int nM, nN, nwg, G, c;
    __host__ __device__ void init(int M, int N, int G_, int c_) { nM = M / BM; nN = N / BM; nwg = nM * nN; G = G_; c = c_; }
    __host__ __device__ bool next(int i, Unit& u) const {
        const long L = (long)i * G + c; if (L >= nwg) return false;
        int wgid = (int)L; { const int q = nwg / NXCD, r = nwg % NXCD, xcd = wgid % NXCD, off = wgid / NXCD; wgid = (xcd < r ? xcd * (q + 1) : r * (q + 1) + (xcd - r) * q) + off; }
        const int nig = WGM * nN, gid = wgid / nig, fm = gid * WGM, gsz = (nM - fm) < WGM ? (nM - fm) : WGM;
        u.pm = fm + ((wgid % nig) % gsz); u.pn = (wgid % nig) / gsz; return true;
    }
    __device__ __forceinline__ void a_ready(const Unit&) const {}
    __device__ __forceinline__ void done(const Unit&) const {}
};

__device__ __forceinline__ unsigned cvt_pk_bf16(float lo, float hi) { unsigned r; asm volatile("v_cvt_pk_bf16_f32 %0, %1, %2" : "=v"(r) : "v"(lo), "v"(hi)); return r; }
template <class Epi, class Sched, bool ALIGN_EPI = false, bool SP2 = false>
__device__ __forceinline__ void gemm_phase(PG8_LAS unsigned char* lds, const Gemm g, const Sched& S, const Epi& E) {
    int tid = threadIdx.x; asm volatile("" : "+v"(tid));
    const int wid = __builtin_amdgcn_readfirstlane(tid >> 6), lane = tid & 63, wr = wid >> 2, wc = wid & 3, fr = lane & 15, fq = lane >> 4;
    const int K = g.K, nt = K / BK;
    unsigned voffA[2], voffB[2];
#pragma unroll
    for (int i = 0; i < 2; ++i) { int R, C; stage_rc(tid * 16 + i * 8192, R, C); const int Rb = Epi::PERM ? ((R & ~31) + perm32(R & 31)) : R;
        voffA[i] = (unsigned)(R * K + C) * 2u; voffB[i] = (unsigned)(Rb * K + C) * 2u; }
    const size_t kstep = (size_t)(BK * 2);
    const size_t hstep = (size_t)HALF * K * 2;
    const size_t tstep = 2 * hstep;
    const unsigned ldsw = (unsigned)wid * 1024u;
    const int aoff = lds_byte(wr * 64 + fr, fq * 8), boff = lds_byte(wc * 32 + fr, fq * 8);
#define PG8_SA(b, h) (((b) * 2 + (h)) * HTB)
#define PG8_SB(b, h) ((4 + (b) * 2 + (h)) * HTB)
#define PG8_STAGE(bufoff, gbase, voff) do { _Pragma("unroll") for (int _i = 0; _i < 2; ++_i) \
        __builtin_amdgcn_global_load_lds((const unsigned*)((const char*)(gbase) + (voff)[_i]), (PG8_LAS unsigned*)(lds + (bufoff) + ldsw + _i * 8192), 16, 0, 0); } while (0)
#define PG8_LDA(dst, b, h) do { _Pragma("unroll") for (int m = 0; m < 4; ++m) _Pragma("unroll") for (int k = 0; k < 2; ++k) dst[m][k] = *(const PG8_LAS bf16x8*)(lds + PG8_SA(b, h) + aoff + m * 2048 + k * 1024); } while (0)
#define PG8_LDB(dst, b, h) do { _Pragma("unroll") for (int n = 0; n < 2; ++n) _Pragma("unroll") for (int k = 0; k < 2; ++k) dst[n][k] = *(const PG8_LAS bf16x8*)(lds + PG8_SB(b, h) + boff + n * 2048 + k * 1024); } while (0)
#define PG8_MMA(ai, bj, At, Bt) do { __builtin_amdgcn_s_setprio(1); _Pragma("unroll") for (int m = 0; m < 4; ++m) _Pragma("unroll") for (int n = 0; n < 2; ++n) _Pragma("unroll") for (int k = 0; k < 2; ++k) \
        acc[ai][bj][m][n] = __builtin_amdgcn_mfma_f32_16x16x32_bf16(Bt[n][k], At[m][k], acc[ai][bj][m][n], 0, 0, 0); __builtin_amdgcn_s_setprio(0); } while (0)
#define PG8_WAIT_V(n) asm volatile("s_waitcnt vmcnt(" #n ")" ::: "memory")
#define PG8_WAIT_L(n) asm volatile("s_waitcnt lgkmcnt(" #n ")" ::: "memory")
#define PG8_BAR __builtin_amdgcn_s_barrier()
#define PG8_SCHED __builtin_amdgcn_sched_barrier(0)
    Unit cur, nxt; int ui = 0;
    if (!S.next(0, cur)) return;
    f32x4 acc[2][2][4][2];
#pragma unroll
    for (int a = 0; a < 2; ++a)
#pragma unroll
        for (int b = 0; b < 2; ++b)
#pragma unroll
            for (int m = 0; m < 4; ++m)
#pragma unroll
                for (int n = 0; n < 2; ++n) acc[a][b][m][n] = (f32x4){0.f, 0.f, 0.f, 0.f};
    bf16x8 At[4][2], B0[2][2], B1[2][2];
    const char* cA = (const char*)g.A + (size_t)cur.pm * tstep; const char* cB = (const char*)g.Bt + (size_t)cur.pn * tstep;
    S.a_ready(cur);
    if constexpr (SP2) {
        PG8_STAGE(PG8_SB(0, 0), cB, voffB); PG8_STAGE(PG8_SB(0, 1), cB + hstep, voffB); PG8_STAGE(PG8_SA(0, 0), cA, voffA); PG8_STAGE(PG8_SA(0, 1), cA + hstep, voffA);
        if (wr == 1) PG8_BAR;
        PG8_WAIT_V(2); PG8_BAR;
        PG8_STAGE(PG8_SB(1, 0), cB + kstep, voffB); PG8_STAGE(PG8_SA(1, 0), cA + kstep, voffA); PG8_STAGE(PG8_SB(1, 1), cB + hstep + kstep, voffB);
        PG8_WAIT_V(6); PG8_BAR;
    } else {
        PG8_STAGE(PG8_SB(0, 0), cB, voffB); PG8_STAGE(PG8_SA(0, 0), cA, voffA); PG8_STAGE(PG8_SB(0, 1), cB + hstep, voffB); PG8_STAGE(PG8_SA(0, 1), cA + hstep, voffA);
        if (wr == 1) PG8_BAR;
        PG8_WAIT_V(4); PG8_BAR;
        PG8_STAGE(PG8_SB(1, 0), cB + kstep, voffB); PG8_STAGE(PG8_SA(1, 0), cA + kstep, voffA); PG8_STAGE(PG8_SB(1, 1), cB + hstep + kstep, voffB);
        PG8_WAIT_V(6); PG8_BAR;
    }
    for (;;) {
        const bool has_next = S.next(ui + 1, nxt);
        const char* nA = has_next ? (const char*)g.A + (size_t)nxt.pm * tstep : cA; const char* nB = has_next ? (const char*)g.Bt + (size_t)nxt.pn * tstep : cB;
#pragma nounroll
        for (int t = 0; t < nt; t += 2) {
            const bool last = (t == nt - 2);
            const char* a1 = cA + (size_t)(t + 1) * kstep;
            const char* a2 = last ? nA : cA + (size_t)(t + 2) * kstep; const char* b2 = last ? nB : cB + (size_t)(t + 2) * kstep;
            const char* a3 = a2 + kstep; const char* b3 = b2 + kstep;
            if (last && has_next) S.a_ready(nxt);
            if constexpr (SP2) {
            PG8_LDB(B0, 0, 0); PG8_LDB(B1, 0, 1); PG8_SCHED; PG8_LDA(At, 0, 0); PG8_STAGE(PG8_SA(1, 1), a1 + hstep, voffA);
            PG8_WAIT_V(8); PG8_WAIT_L(0); PG8_BAR; PG8_MMA(0, 0, At, B0); PG8_MMA(0, 1, At, B1); PG8_BAR; PG8_SCHED;
            PG8_LDA(At, 0, 1); PG8_STAGE(PG8_SB(0, 0), b2, voffB); PG8_STAGE(PG8_SB(0, 1), b2 + hstep, voffB); PG8_STAGE(PG8_SA(0, 0), a2, voffA);
            PG8_WAIT_V(8); PG8_WAIT_L(0); PG8_BAR; PG8_MMA(1, 0, At, B0); PG8_MMA(1, 1, At, B1); PG8_BAR; PG8_SCHED;
            PG8_LDB(B0, 1, 0); PG8_LDB(B1, 1, 1); PG8_SCHED; PG8_LDA(At, 1, 0); PG8_STAGE(PG8_SA(0, 1), a2 + hstep, voffA);
            PG8_WAIT_V(8); PG8_WAIT_L(0); PG8_BAR; PG8_MMA(0, 0, At, B0); PG8_MMA(0, 1, At, B1); PG8_BAR; PG8_SCHED;
            PG8_LDA(At, 1, 1); PG8_STAGE(PG8_SB(1, 0), b3, voffB); PG8_STAGE(PG8_SB(1, 1), b3 + hstep, voffB); PG8_STAGE(PG8_SA(1, 0), a3, voffA);
            PG8_WAIT_V(8); PG8_WAIT_L(0); PG8_BAR; PG8_MMA(1, 0, At, B0); PG8_MMA(1, 1, At, B1); PG8_BAR; PG8_SCHED;
            } else {
            PG8_LDB(B0, 0, 0); PG8_SCHED; PG8_LDA(At, 0, 0); PG8_STAGE(PG8_SA(1, 1), a1 + hstep, voffA);
            PG8_WAIT_L(8); PG8_BAR; PG8_WAIT_L(0); PG8_MMA(0, 0, At, B0); PG8_BAR; PG8_SCHED;
            PG8_LDB(B1, 0, 1); PG8_STAGE(PG8_SB(0, 0), b2, voffB);
            PG8_BAR; PG8_WAIT_L(0); PG8_MMA(0, 1, At, B1); PG8_BAR;
            PG8_LDA(At, 0, 1); PG8_STAGE(PG8_SA(0, 0), a2, voffA);
            PG8_BAR; PG8_WAIT_L(0); PG8_MMA(1, 0, At, B0); PG8_BAR; PG8_SCHED;
            PG8_STAGE(PG8_SB(0, 1), b2 + hstep, voffB);
            PG8_WAIT_V(6); PG8_BAR; PG8_MMA(1, 1, At, B1); PG8_BAR;
            PG8_LDB(B0, 1, 0); PG8_SCHED; PG8_LDA(At, 1, 0); PG8_STAGE(PG8_SA(0, 1), a2 + hstep, voffA);
            PG8_WAIT_L(8); PG8_BAR; PG8_WAIT_L(0); PG8_MMA(0, 0, At, B0); PG8_BAR; PG8_SCHED;
            PG8_LDB(B1, 1, 1); PG8_STAGE(PG8_SB(1, 0), b3, voffB);
            PG8_BAR; PG8_WAIT_L(0); PG8_MMA(0, 1, At, B1); PG8_BAR;
            PG8_LDA(At, 1, 1); PG8_STAGE(PG8_SA(1, 0), a3, voffA);
            PG8_BAR; PG8_WAIT_L(0); PG8_MMA(1, 0, At, B0); PG8_BAR; PG8_SCHED;
            PG8_STAGE(PG8_SB(1, 1), b3 + hstep, voffB);
            PG8_WAIT_V(6); PG8_BAR; PG8_MMA(1, 1, At, B1); PG8_BAR;
            }
        }
        if constexpr (ALIGN_EPI) { if (wr == 0) PG8_BAR; }
        if constexpr (!Epi::AFTER_DRAIN) { E(acc, cur, wr, wc, fr, fq); S.done(cur); }
        if (!has_next) break;
#pragma unroll
        for (int a = 0; a < 2; ++a)
#pragma unroll
            for (int b = 0; b < 2; ++b)
#pragma unroll
                for (int m = 0; m < 4; ++m)
#pragma unroll
                    for (int n = 0; n < 2; ++n) acc[a][b][m][n] = (f32x4){0.f, 0.f, 0.f, 0.f};
        cur = nxt; cA = nA; cB = nB; ++ui;
        if constexpr (ALIGN_EPI) { if (wr == 1) PG8_BAR; }
    }
    PG8_WAIT_V(0);
    if constexpr (!ALIGN_EPI) { if (wr == 0) PG8_BAR; }
    PG8_BAR;
    if constexpr (Epi::AFTER_DRAIN) { E.fused(acc, cur, wr, wc, fr, fq, lds, wid, lane); S.done(cur); }
#undef PG8_SA
#undef PG8_SB
#undef PG8_STAGE
#undef PG8_LDA
#undef PG8_LDB
#undef PG8_MMA
#undef PG8_WAIT_V
#undef PG8_WAIT_L
#undef PG8_BAR
#undef PG8_SCHED
}
}

#define LAS __attribute__((address_space(3)))
using pg8::bf16_t; using pg8::bf16x8; using pg8::f32x4; using pg8::u32x4;
typedef float f32x16 __attribute__((ext_vector_type(16)));
typedef float f32x2v __attribute__((ext_vector_type(2)));
typedef unsigned u32x2v __attribute__((ext_vector_type(2)));
typedef short v4i16_t __attribute__((ext_vector_type(4)));
constexpr int BATCH = 16, SEQ = 2048, DM = 1024, M = BATCH * SEQ, DFF = 2816;
constexpr float ALPHA = 1.41421356237309515f, LOG2E = 1.4426950408889634f;
constexpr float QS_A = 0.125f * LOG2E, QS_B = 0.10206207261596577f * LOG2E, QS_C = 0.125f * LOG2E;
constexpr float LAMBDA_INIT = 0.8f - 0.6f * 0.74081822068171788f;
constexpr float NEG_BIG = -1e30f;
constexpr size_t MiB = (size_t)1 << 20;
constexpr size_t WS_W_IN = 1 * MiB;
constexpr size_t WS_W_QUP = WS_W_IN + (size_t)2304 * 1024 * 2;
constexpr size_t WS_W_KVUP = WS_W_QUP + (size_t)768 * 384 * 2;
constexpr size_t WS_W_OUT0 = WS_W_KVUP + (size_t)1024 * 256 * 2;
constexpr size_t WS_W_OUT1 = WS_W_OUT0 + 2 * MiB;
constexpr size_t WS_W_CQKV = WS_W_OUT1 + 2 * MiB;
constexpr size_t WS_W_GATE = WS_W_CQKV + 6 * MiB;
constexpr size_t WSZ_FF = (size_t)2816 * 1024 * 2;
constexpr size_t WS_W_UP = WS_W_GATE + 2 * WSZ_FF;
constexpr size_t WS_W_DOWN = WS_W_UP + 2 * WSZ_FF;
constexpr size_t WS_W_PG = WS_W_DOWN + 2 * WSZ_FF;
constexpr size_t WS_W_PP = WS_W_PG + 4 * MiB;
constexpr size_t WS_W_END = WS_W_PP + 2 * (size_t)1024 * 256 * 2;
static_assert(WS_W_END <= 58 * MiB, "weights region");
constexpr size_t WS_ROPEA = 58 * MiB, WS_ROPEB = 60 * MiB;
constexpr size_t WS_XB = 64 * MiB, WS_PB = 128 * MiB, WS_PJ = 160 * MiB, WS_MIX = 160 * MiB;
constexpr size_t WS_QA = 224 * MiB, WS_KA = 256 * MiB, WS_VA = 288 * MiB, WS_KB = 320 * MiB, WS_LAT = 368 * MiB, WS_OA = 368 * MiB, WS_LSE = 464 * MiB;
constexpr size_t DO_CQN = 0, DO_CKVN = 24 * MiB, DO_QB = 40 * MiB, DO_VB = 88 * MiB;
constexpr size_t WS_FA = 160 * MiB, WS_FG = 336 * MiB;
constexpr size_t WS_QC = 160 * MiB, WS_KC = 224 * MiB, WS_VC = 288 * MiB, WS_O01 = 352 * MiB;
constexpr size_t WS_XB2 = 448 * MiB;
constexpr size_t WS_NEED = 512 * MiB;
constexpr int LDS_BYTES = 131072 + 1024;

__device__ __forceinline__ unsigned cvt_pk(float lo, float hi) { return pg8::cvt_pk_bf16(lo, hi); }
__device__ __forceinline__ float bf_lo(unsigned w) { return __uint_as_float(w << 16); }
__device__ __forceinline__ float bf_hi(unsigned w) { return __uint_as_float(w & 0xffff0000u); }
__device__ __forceinline__ u32x4 pack8(f32x4 a, f32x4 b) { u32x4 w; w.x = cvt_pk(a[0], a[1]); w.y = cvt_pk(a[2], a[3]); w.z = cvt_pk(b[0], b[1]); w.w = cvt_pk(b[2], b[3]); return w; }
__device__ __forceinline__ void unpack8(u32x4 w, f32x4& a, f32x4& b) { a = (f32x4){bf_lo(w.x), bf_hi(w.x), bf_lo(w.y), bf_hi(w.y)}; b = (f32x4){bf_lo(w.z), bf_hi(w.z), bf_lo(w.w), bf_hi(w.w)}; }
__device__ __forceinline__ float fexp2(float x) { return __builtin_amdgcn_exp2f(x); }
__device__ __forceinline__ float wave_sum(float v) {
#pragma unroll
    for (int o = 1; o < 64; o <<= 1) v += __shfl_xor(v, o);
    return v;
}
__device__ __forceinline__ void rope8(f32x4& v0, f32x4& v1, const float* tab) {
    const f32x4 t0 = *(const f32x4*)tab, t1 = *(const f32x4*)(tab + 4);
    float a, b;
    a = v0[0]; b = v0[1]; v0[0] = a * t0[0] - b * t0[1]; v0[1] = b * t0[0] + a * t0[1];
    a = v0[2]; b = v0[3]; v0[2] = a * t0[2] - b * t0[3]; v0[3] = b * t0[2] + a * t0[3];
    a = v1[0]; b = v1[1]; v1[0] = a * t1[0] - b * t1[1]; v1[1] = b * t1[0] + a * t1[1];
    a = v1[2]; b = v1[3]; v1[2] = a * t1[2] - b * t1[3]; v1[3] = b * t1[2] + a * t1[3];
}

struct NoCtx {};
template <class F> struct Epi8 {
    static constexpr bool PERM = true, AFTER_DRAIN = false; F f;
    __device__ __forceinline__ void operator()(const f32x4 (&acc)[2][2][4][2], const pg8::Unit& u, int wr, int wc, int fr, int fq) const {
        const int row0 = u.pm * 256 + wr * 64 + fr, col0 = u.pn * 256 + wc * 32 + 8 * fq;
#pragma unroll
        for (int bj = 0; bj < 2; ++bj) {
            const int c0 = col0 + bj * 128; typename F::Ctx ctx; f.prep(c0, ctx);
#pragma unroll
            for (int ai = 0; ai < 2; ++ai)
#pragma unroll
                for (int m = 0; m < 4; ++m) f.apply(row0 + ai * 128 + m * 16, c0, acc[ai][bj][m][0], acc[ai][bj][m][1], ctx);
        }
    }
};
struct FWin {
    typedef NoCtx Ctx; bf16_t *QA, *KA, *VA; float* LAT; bf16_t* KB; const float *ropeA, *ropeB;
    __device__ __forceinline__ void prep(int, Ctx&) const {}
    __device__ __forceinline__ void apply(int row, int c0, f32x4 v0, f32x4 v1, const Ctx&) const {
        if (c0 < 1536) {
            const int sec = c0 >> 9, cc = c0 & 511;
            if (sec < 2 && (cc & 63) < 16) rope8(v0, v1, ropeA + (size_t)row * 16 + (cc & 63));
            if (sec == 0) { v0 = v0 * QS_A; v1 = v1 * QS_A; }
            bf16_t* dst = (sec == 0 ? QA : (sec == 1 ? KA : VA)) + (size_t)row * 512 + cc;
            *(u32x4*)dst = pack8(v0, v1);
        } else if (c0 < 2176) {
            float* dst = LAT + (size_t)row * 640 + (c0 - 1536);
            *(f32x4*)dst = v0; *(f32x4*)(dst + 4) = v1;
        } else if (c0 < 2208) {
            const int j = c0 - 2176;
            rope8(v0, v1, ropeB + (size_t)row * 32 + j);
            const u32x4 w = pack8(v0, v1);
            bf16_t* dst = KB + (size_t)row * 768 + 64 + j;
#pragma unroll
            for (int h = 0; h < 8; ++h) *(u32x4*)(dst + h * 96) = w;
        }
    }
};
struct FQup {
    typedef NoCtx Ctx; bf16_t* QB; const float* ropeB;
    __device__ __forceinline__ void prep(int, Ctx&) const {}
    __device__ __forceinline__ void apply(int row, int c0, f32x4 v0, f32x4 v1, const Ctx&) const {
        const int w = c0 % 96;
        if (w >= 64) rope8(v0, v1, ropeB + (size_t)row * 32 + (w - 64));
        v0 = v0 * QS_B; v1 = v1 * QS_B;
        *(u32x4*)(QB + (size_t)row * 768 + c0) = pack8(v0, v1);
    }
};
struct FKvup {
    typedef NoCtx Ctx; bf16_t *KB, *VB;
    __device__ __forceinline__ void prep(int, Ctx&) const {}
    __device__ __forceinline__ void apply(int row, int c0, f32x4 v0, f32x4 v1, const Ctx&) const {
        const u32x4 w = pack8(v0, v1);
        if (c0 < 512) *(u32x4*)(KB + (size_t)row * 768 + (c0 >> 6) * 96 + (c0 & 63)) = w;
        else *(u32x4*)(VB + (size_t)row * 512 + (c0 - 512)) = w;
    }
};
struct FResid {
    typedef NoCtx Ctx; const float* res; float* out;
    __device__ __forceinline__ void prep(int, Ctx&) const {}
    __device__ __forceinline__ void apply(int row, int c0, f32x4 v0, f32x4 v1, const Ctx&) const {
        const size_t o = (size_t)row * DM + c0;
        const f32x4 r0 = *(const f32x4*)(res + o), r1 = *(const f32x4*)(res + o + 4);
        *(f32x4*)(out + o) = r0 * ALPHA + v0; *(f32x4*)(out + o + 4) = r1 * ALPHA + v1;
    }
};
struct FBf16 {
    typedef NoCtx Ctx; bf16_t* O; int ld;
    __device__ __forceinline__ void prep(int, Ctx&) const {}
    __device__ __forceinline__ void apply(int row, int c0, f32x4 v0, f32x4 v1, const Ctx&) const { *(u32x4*)(O + (size_t)row * ld + c0) = pack8(v0, v1); }
};
__device__ __forceinline__ float gelu_tanh(float c) {
    const float z = 0.7978845608028654f * (c + 0.044715f * c * c * c);
    return c * __builtin_amdgcn_rcpf(1.0f + fexp2(-2.0f * LOG2E * z));
}
struct FUpConv {
    struct Ctx { f32x4 w0[2], w1[2], w2[2], b[2]; };
    const bf16_t* A; bf16_t* Gout; const float* cw; const float* cb;
    __device__ __forceinline__ void prep(int c0, Ctx& c) const {
#pragma unroll
        for (int i = 0; i < 2; ++i) { c.w0[i] = *(const f32x4*)(cw + c0 + 4 * i); c.w1[i] = *(const f32x4*)(cw + DFF + c0 + 4 * i); c.w2[i] = *(const f32x4*)(cw + 2 * DFF + c0 + 4 * i); c.b[i] = *(const f32x4*)(cb + c0 + 4 * i); }
    }
    __device__ __forceinline__ void apply(int row, int c0, f32x4 v0, f32x4 v1, const Ctx& c) const {
        const int t = row & (SEQ - 1);
        const bf16_t* ap = A + (size_t)row * DFF + c0;
        const u32x4 z = (u32x4){0u, 0u, 0u, 0u};
        const u32x4 wm = t > 0 ? *(const u32x4*)(ap - DFF) : z, w0 = *(const u32x4*)ap, wp = t < SEQ - 1 ? *(const u32x4*)(ap + DFF) : z;
        f32x4 am0, am1, a00, a01, ap0, ap1; unpack8(wm, am0, am1); unpack8(w0, a00, a01); unpack8(wp, ap0, ap1);
        f32x4 c0v = c.b[0] + c.w0[0] * am0 + c.w1[0] * a00 + c.w2[0] * ap0;
        f32x4 c1v = c.b[1] + c.w0[1] * am1 + c.w1[1] * a01 + c.w2[1] * ap1;
#pragma unroll
        for (int e = 0; e < 4; ++e) { c0v[e] = gelu_tanh(c0v[e]) * v0[e]; c1v[e] = gelu_tanh(c1v[e]) * v1[e]; }
        *(u32x4*)(Gout + (size_t)row * DFF + c0) = pack8(c0v, c1v);
    }
};
struct FPle {
    typedef NoCtx Ctx; float* XF; const bf16_t* PJ; bf16_t* XB;
    __device__ __forceinline__ void prep(int, Ctx&) const {}
    __device__ __forceinline__ void apply(int row, int c0, f32x4 v0, f32x4 v1, const Ctx&) const {
        const size_t o = (size_t)row * DM + c0;
        f32x4 x0 = *(const f32x4*)(XF + o), x1 = *(const f32x4*)(XF + o + 4), p0, p1; unpack8(*(const u32x4*)(PJ + o), p0, p1);
#pragma unroll
        for (int e = 0; e < 4; ++e) { x0[e] += p0[e] * __builtin_amdgcn_rcpf(1.0f + fexp2(-LOG2E * v0[e])); x1[e] += p1[e] * __builtin_amdgcn_rcpf(1.0f + fexp2(-LOG2E * v1[e])); }
        *(f32x4*)(XF + o) = x0; *(f32x4*)(XF + o + 4) = x1; *(u32x4*)(XB + o) = pack8(x0, x1);
    }
};
struct FCqkv {
    typedef NoCtx Ctx; bf16_t *Q, *K, *V; const float* ropeA;
    __device__ __forceinline__ void prep(int, Ctx&) const {}
    __device__ __forceinline__ void apply(int row, int c0, f32x4 v0, f32x4 v1, const Ctx&) const {
        const int sec = c0 >> 10, cc = c0 & 1023;
        if (sec < 2 && (cc & 63) < 16) rope8(v0, v1, ropeA + (size_t)row * 16 + (cc & 63));
        if (sec == 0) { v0 = v0 * QS_C; v1 = v1 * QS_C; }
        bf16_t* dst = (sec == 0 ? Q : (sec == 1 ? K : V)) + (size_t)row * 1024 + cc;
        *(u32x4*)dst = pack8(v0, v1);
    }
};
template <class F> __device__ __forceinline__ void run_gemm(LAS unsigned char* lds, const bf16_t* A, const bf16_t* Bt, int N, int K, int G, const F& f) {
    pg8::Gemm g{A, Bt, M, N, K}; pg8::StaticOrder S; S.init(M, N, G, (int)blockIdx.x);
    Epi8<F> E{f};
    pg8::gemm_phase<Epi8<F>, pg8::StaticOrder, true, true>(lds, g, S, E);
}

struct MapId { __device__ __forceinline__ int operator()(int n) const { return n; } };
__device__ __forceinline__ int il16(int w) { return (w & 1) ? 8 + (w >> 1) : (w >> 1); }
__device__ __forceinline__ int il32(int w) { return (w & 1) ? 16 + (w >> 1) : (w >> 1); }
struct MapRope64 { int lim; __device__ __forceinline__ int operator()(int n) const { if (n < lim) { const int w = n & 63; if (w < 16) return (n - w) + il16(w); } return n; } };
struct MapWin { __device__ __forceinline__ int operator()(int n) const {
    if (n < 1024) { const int w = n & 63; return w < 16 ? (n - w) + il16(w) : n; }
    if (n < 2176) return n;
    if (n < 2208) return 2176 + il32(n - 2176);
    return -1; } };
struct MapQup { __device__ __forceinline__ int operator()(int n) const { const int w = n % 96; return w >= 64 ? (n - w) + 64 + il32(w - 64) : n; } };
struct MapKvup { __device__ __forceinline__ int operator()(int n) const { if (n < 512) return (n >> 6) * 128 + (n & 63); const int m = n - 512; return (m >> 6) * 128 + 64 + (m & 63); } };
template <class Map> __device__ __forceinline__ void prep_weight(const float* __restrict__ W, int K, int ldw, bf16_t* __restrict__ WT, int Nout, Map map, LAS float* scr, int gw, int NGW, int lane) {
    const int nblk = Nout / 32, nitems = (K / 64) * nblk;
    for (int it = gw; it < nitems; it += NGW) {
        const int kb = it / nblk, nb = it % nblk, k0 = 64 * kb, n0 = 32 * nb;
        const int src = map(n0 + (lane & 31));
#pragma unroll 8
        for (int i = 0; i < 32; ++i) { const int kk = 2 * i + (lane >> 5); scr[kk * 33 + (lane & 31)] = src >= 0 ? W[(size_t)(k0 + kk) * ldw + src] : 0.f; }
        asm volatile("s_waitcnt lgkmcnt(0)" ::: "memory");
        const int c = lane & 7;
#pragma unroll
        for (int j = 0; j < 4; ++j) { const int n = (lane >> 3) + 8 * j; const LAS float* s = scr + (8 * c) * 33 + n;
            u32x4 o; o.x = cvt_pk(s[0 * 33], s[1 * 33]); o.y = cvt_pk(s[2 * 33], s[3 * 33]); o.z = cvt_pk(s[4 * 33], s[5 * 33]); o.w = cvt_pk(s[6 * 33], s[7 * 33]);
            *(u32x4*)(WT + (size_t)(n0 + n) * K + k0 + 8 * c) = o; }
        asm volatile("s_waitcnt lgkmcnt(0)" ::: "memory");
    }
}

__device__ __forceinline__ void ln_phase(float* XF, bf16_t* XB, const float* __restrict__ g, const float* __restrict__ b, int gw, int NGW, int lane) {
    f32x4 gv[4], bv[4];
#pragma unroll
    for (int j = 0; j < 4; ++j) { gv[j] = ((const f32x4*)g)[lane + 64 * j]; bv[j] = ((const f32x4*)b)[lane + 64 * j]; }
    for (int row = gw; row < M; row += NGW) {
        f32x4* xr = (f32x4*)(XF + (size_t)row * DM) + lane;
        f32x4 v[4]; float s = 0.f;
#pragma unroll
        for (int j = 0; j < 4; ++j) { v[j] = xr[64 * j]; s += (v[j][0] + v[j][1]) + (v[j][2] + v[j][3]); }
        const float mean = wave_sum(s) * (1.f / DM); float s2 = 0.f;
#pragma unroll
        for (int j = 0; j < 4; ++j) { v[j] = v[j] - mean; s2 += (v[j][0] * v[j][0] + v[j][1] * v[j][1]) + (v[j][2] * v[j][2] + v[j][3] * v[j][3]); }
        const float rstd = 1.f / sqrtf(wave_sum(s2) * (1.f / DM) + 1e-5f);
        u32x2v* ob = (u32x2v*)(XB + (size_t)row * DM) + lane;
#pragma unroll
        for (int j = 0; j < 4; ++j) { const f32x4 y = v[j] * rstd * gv[j] + bv[j]; xr[64 * j] = y; u32x2v w; w.x = cvt_pk(y[0], y[1]); w.y = cvt_pk(y[2], y[3]); ob[64 * j] = w; }
    }
}
__device__ __forceinline__ void latnorm_phase(const float* __restrict__ LAT, bf16_t* __restrict__ CQN, bf16_t* __restrict__ CKVN, const float* __restrict__ qn, const float* __restrict__ kvn, int gw, int NGW, int lane) {
    f32x2v gq[3];
#pragma unroll
    for (int j = 0; j < 3; ++j) gq[j] = *(const f32x2v*)(qn + 2 * lane + 128 * j);
    const f32x4 gk = *(const f32x4*)(kvn + 4 * lane);
    for (int row = gw; row < M; row += NGW) {
        const float* lr = LAT + (size_t)row * 640;
        f32x2v q[3]; float s = 0.f;
#pragma unroll
        for (int j = 0; j < 3; ++j) { q[j] = *(const f32x2v*)(lr + 2 * lane + 128 * j); s += q[j][0] * q[j][0] + q[j][1] * q[j][1]; }
        const f32x4 kv = *(const f32x4*)(lr + 384 + 4 * lane);
        float s2 = (kv[0] * kv[0] + kv[1] * kv[1]) + (kv[2] * kv[2] + kv[3] * kv[3]);
        const float rq = 1.f / sqrtf(wave_sum(s) * (1.f / 384.f) + 1e-6f), rk = 1.f / sqrtf(wave_sum(s2) * (1.f / 256.f) + 1e-6f);
#pragma unroll
        for (int j = 0; j < 3; ++j) *(unsigned*)(CQN + (size_t)row * 384 + 2 * lane + 128 * j) = cvt_pk(q[j][0] * rq * gq[j][0], q[j][1] * rq * gq[j][1]);
        u32x2v w; w.x = cvt_pk(kv[0] * rk * gk[0], kv[1] * rk * gk[1]); w.y = cvt_pk(kv[2] * rk * gk[2], kv[3] * rk * gk[3]);
        *(u32x2v*)(CKVN + (size_t)row * 256 + 4 * lane) = w;
    }
}
__device__ __forceinline__ void merge_phase(const bf16_t* __restrict__ OA, const float* __restrict__ LSE, bf16_t* __restrict__ MIX, int gw, int NGW, int lane) {
    for (int row = gw; row < M; row += NGW) {
        const int h = lane >> 3;
        const float l0 = LSE[((size_t)0 * M + row) * 8 + h], l1 = LSE[((size_t)1 * M + row) * 8 + h], l2 = LSE[((size_t)2 * M + row) * 8 + h];
        const float mx = fmaxf(l0, fmaxf(l1, l2));
        float w0 = fexp2(l0 - mx), w1 = fexp2(l1 - mx), w2 = fexp2(l2 - mx); const float inv = 1.f / (w0 + w1 + w2); w0 *= inv; w1 *= inv; w2 *= inv;
        f32x4 a0, a1, b0, b1, c0, c1;
        unpack8(*(const u32x4*)(OA + ((size_t)0 * M + row) * 512 + 8 * lane), a0, a1);
        unpack8(*(const u32x4*)(OA + ((size_t)1 * M + row) * 512 + 8 * lane), b0, b1);
        unpack8(*(const u32x4*)(OA + ((size_t)2 * M + row) * 512 + 8 * lane), c0, c1);
        *(u32x4*)(MIX + (size_t)row * 1024 + 8 * lane) = pack8(a0 * w0 + b0 * w1 + c0 * w2, a1 * w0 + b1 * w1 + c1 * w2);
    }
}
__device__ __forceinline__ void diffcomb_phase(const bf16_t* __restrict__ O01, bf16_t* __restrict__ MIX, const float* __restrict__ lamp, const float* __restrict__ subln, int gw, int NGW, int lane) {
    const float s01 = wave_sum(lamp[lane] * lamp[64 + lane]), s23 = wave_sum(lamp[128 + lane] * lamp[192 + lane]);
    const float lam = expf(s01) - expf(s23) + LAMBDA_INIT;
    const int h = lane >> 3, d0 = (lane & 7) * 16;
    f32x4 gsub[4];
#pragma unroll
    for (int j = 0; j < 4; ++j) gsub[j] = *(const f32x4*)(subln + d0 + 4 * j) * (1.0f - LAMBDA_INIT);
    for (int row = gw; row < M; row += NGW) {
        const bf16_t* p0 = O01 + (size_t)row * 2048 + (2 * h) * 128 + d0; const bf16_t* p1 = p0 + 128;
        f32x4 a[4], b[4];
        unpack8(*(const u32x4*)p0, a[0], a[1]); unpack8(*(const u32x4*)(p0 + 8), a[2], a[3]);
        unpack8(*(const u32x4*)p1, b[0], b[1]); unpack8(*(const u32x4*)(p1 + 8), b[2], b[3]);
        float ss = 0.f;
#pragma unroll
        for (int j = 0; j < 4; ++j) { a[j] = a[j] - b[j] * lam; ss += (a[j][0] * a[j][0] + a[j][1] * a[j][1]) + (a[j][2] * a[j][2] + a[j][3] * a[j][3]); }
        ss += __shfl_xor(ss, 1); ss += __shfl_xor(ss, 2); ss += __shfl_xor(ss, 4);
        const float r = 1.f / sqrtf(ss * (1.f / 128.f) + 1e-5f);
#pragma unroll
        for (int j = 0; j < 4; ++j) a[j] = a[j] * r * gsub[j];
        bf16_t* o = MIX + (size_t)row * 1024 + h * 128 + d0;
        *(u32x4*)o = pack8(a[0], a[1]); *(u32x4*)(o + 8) = pack8(a[2], a[3]);
    }
}

__device__ __forceinline__ bf16x8 tr2(const LAS unsigned char* p0, const LAS unsigned char* p1) {
    const v4i16_t a = __builtin_amdgcn_ds_read_tr16_b64_v4i16((LAS v4i16_t*)p0), b = __builtin_amdgcn_ds_read_tr16_b64_v4i16((LAS v4i16_t*)p1);
    return (bf16x8){a[0], a[1], a[2], a[3], b[0], b[1], b[2], b[3]};
}
__device__ __forceinline__ bf16x8 packp(const f32x16& p, int b) {
    u32x4 w; w.x = cvt_pk(p[b], p[b + 1]); w.y = cvt_pk(p[b + 2], p[b + 3]); w.z = cvt_pk(p[b + 4], p[b + 5]); w.w = cvt_pk(p[b + 6], p[b + 7]);
    return __builtin_bit_cast(bf16x8, w);
}
template <int DQ, int DV>
__device__ __forceinline__ void attn_dense_unit(LAS unsigned char* lds, const bf16_t* __restrict__ Qp, int ldq, const bf16_t* __restrict__ Kp, int ldk,
                                                const bf16_t* __restrict__ Vp, int ldv, bf16_t* __restrict__ Op, int ldo, int tid) {
    constexpr int KS = DQ + 8, VS = (DV == 64) ? 96 : 160;
    constexpr int KBUF = 64 * KS * 2, VBUF = 64 * VS * 2;
    constexpr int CK = DQ / 8, CV = DV / 8, NKC = 64 * CK, NVC = 64 * CV, NKL = (NKC + 511) / 512, NVL = (NVC + 511) / 512, NT = SEQ / 64, ND = DV / 32;
    const int lane = tid & 63, wave = tid >> 6, r32 = lane & 31, hi = lane >> 5;
    int kgo[NKL], klo[NKL], vgo[NVL], vlo[NVL];
#pragma unroll
    for (int i = 0; i < NKL; ++i) { const int id = tid + 512 * i, row = id / CK, ch = id % CK; kgo[i] = row * ldk + ch * 8; klo[i] = row * KS * 2 + ch * 16; }
#pragma unroll
    for (int i = 0; i < NVL; ++i) { const int id = tid + 512 * i, row = id / CV, ch = id % CV; vgo[i] = row * ldv + ch * 8; vlo[i] = 2 * KBUF + row * VS * 2 + ch * 16; }
    u32x4 kreg[NKL], vreg[NVL];
#define ATT_LOAD(t) do { _Pragma("unroll") for (int i = 0; i < NKL; ++i) if (tid + 512 * i < NKC) kreg[i] = *(const u32x4*)(Kp + (size_t)(t) * 64 * ldk + kgo[i]); \
                         _Pragma("unroll") for (int i = 0; i < NVL; ++i) if (tid + 512 * i < NVC) vreg[i] = *(const u32x4*)(Vp + (size_t)(t) * 64 * ldv + vgo[i]); } while (0)
#define ATT_STORE(buf) do { _Pragma("unroll") for (int i = 0; i < NKL; ++i) if (tid + 512 * i < NKC) *(LAS u32x4*)(lds + (buf) * KBUF + klo[i]) = kreg[i]; \
                            _Pragma("unroll") for (int i = 0; i < NVL; ++i) if (tid + 512 * i < NVC) *(LAS u32x4*)(lds + (buf) * VBUF + vlo[i]) = vreg[i]; } while (0)
    ATT_LOAD(0);
    bf16x8 qf[DQ / 16];
#pragma unroll
    for (int d = 0; d < DQ / 16; ++d) qf[d] = *(const bf16x8*)(Qp + (size_t)(wave * 32 + r32) * ldq + 16 * d + 8 * hi);
    ATT_STORE(0);
    __syncthreads();
    float m = NEG_BIG, lsum = 0.f; f32x16 O[ND];
#pragma unroll
    for (int d = 0; d < ND; ++d)
#pragma unroll
        for (int r = 0; r < 16; ++r) O[d][r] = 0.f;
    const int kboff = r32 * KS * 2 + hi * 16;
    const int vboff = 2 * KBUF + ((4 * hi + ((lane & 15) >> 2)) * VS + 16 * ((lane >> 4) & 1) + 4 * (lane & 3)) * 2;
    for (int t = 0; t < NT; ++t) {
        const int cur = t & 1;
        if (t + 1 < NT) ATT_LOAD(t + 1);
        const LAS unsigned char* kb = lds + cur * KBUF + kboff;
        f32x16 p0, p1;
#pragma unroll
        for (int r = 0; r < 16; ++r) { p0[r] = 0.f; p1[r] = 0.f; }
#pragma unroll
        for (int d = 0; d < DQ / 16; ++d) {
            const bf16x8 k0 = *(const LAS bf16x8*)(kb + d * 32), k1 = *(const LAS bf16x8*)(kb + 32 * KS * 2 + d * 32);
            p0 = __builtin_amdgcn_mfma_f32_32x32x16_bf16(k0, qf[d], p0, 0, 0, 0);
            p1 = __builtin_amdgcn_mfma_f32_32x32x16_bf16(k1, qf[d], p1, 0, 0, 0);
        }
        float mx = fmaxf(p0[0], p1[0]);
#pragma unroll
        for (int r = 1; r < 16; ++r) mx = fmaxf(mx, fmaxf(p0[r], p1[r]));
        mx = fmaxf(mx, __shfl_xor(mx, 32));
        const float mn = fmaxf(m, mx), al = fexp2(m - mn); m = mn;
        float rs = 0.f;
#pragma unroll
        for (int r = 0; r < 16; ++r) { p0[r] = fexp2(p0[r] - mn); p1[r] = fexp2(p1[r] - mn); rs += p0[r] + p1[r]; }
        lsum = lsum * al + rs;
#pragma unroll
        for (int d = 0; d < ND; ++d)
#pragma unroll
            for (int r = 0; r < 16; ++r) O[d][r] *= al;
        bf16x8 pf[4]; pf[0] = packp(p0, 0); pf[1] = packp(p0, 8); pf[2] = packp(p1, 0); pf[3] = packp(p1, 8);
        const LAS unsigned char* vb = lds + cur * VBUF + vboff;
#pragma unroll
        for (int d = 0; d < ND; ++d)
#pragma unroll
            for (int s = 0; s < 4; ++s) {
                const bf16x8 vf = tr2(vb + (16 * s) * VS * 2 + d * 64, vb + (16 * s + 8) * VS * 2 + d * 64);
                O[d] = __builtin_amdgcn_mfma_f32_32x32x16_bf16(vf, pf[s], O[d], 0, 0, 0);
            }
        if (t + 1 < NT) ATT_STORE(cur ^ 1);
        __syncthreads();
    }
#undef ATT_LOAD
#undef ATT_STORE
    const float l = lsum + __shfl_xor(lsum, 32), inv = 1.f / l;
    bf16_t* orow = Op + (size_t)(wave * 32 + r32) * ldo + 4 * hi;
#pragma unroll
    for (int d = 0; d < ND; ++d)
#pragma unroll
        for (int g = 0; g < 4; ++g) { u32x2v w; w.x = cvt_pk(O[d][4 * g] * inv, O[d][4 * g + 1] * inv); w.y = cvt_pk(O[d][4 * g + 2] * inv, O[d][4 * g + 3] * inv); *(u32x2v*)(orow + 32 * d + 8 * g) = w; }
}
__device__ __forceinline__ void attn_dilated_unit(LAS unsigned char* wl, const bf16_t* __restrict__ QA, const bf16_t* __restrict__ KA, const bf16_t* __restrict__ VA,
                                                  bf16_t* __restrict__ OAp, float* __restrict__ LSEp, int b, int h, int shift, int r, int lb, int lane) {
    constexpr int VS = 96;
    const int r32 = lane & 31, hi = lane >> 5, L = SEQ >> shift, l0 = lb * 32;
    const size_t rowb = (size_t)b * SEQ;
    const int tq = ((l0 + r32) << shift) + r;
    bf16x8 qf[4];
#pragma unroll
    for (int d = 0; d < 4; ++d) qf[d] = *(const bf16x8*)(QA + (rowb + tq) * 512 + h * 64 + 16 * d + 8 * hi);
    float m = NEG_BIG, lsum = 0.f; f32x16 O[2];
#pragma unroll
    for (int d = 0; d < 2; ++d)
#pragma unroll
        for (int q = 0; q < 16; ++q) O[d][q] = 0.f;
    const int vboff = ((4 * hi + ((lane & 15) >> 2)) * VS + 16 * ((lane >> 4) & 1) + 4 * (lane & 3)) * 2;
    for (int j = 0; j < 5; ++j) {
        const int kl0 = l0 - 64 + 32 * j;
        if (kl0 + 31 < 0 || kl0 >= L) continue;
        int kl = kl0 + r32; kl = kl < 0 ? 0 : (kl > L - 1 ? L - 1 : kl);
        const bf16_t* kp = KA + (rowb + (size_t)((kl << shift) + r)) * 512 + h * 64 + 8 * hi;
        bf16x8 kf[4];
#pragma unroll
        for (int d = 0; d < 4; ++d) kf[d] = *(const bf16x8*)(kp + 16 * d);
        u32x4 vreg[4];
#pragma unroll
        for (int i = 0; i < 4; ++i) { const int id = lane + 64 * i, vrow = id >> 3, ch = id & 7; int kv = kl0 + vrow; kv = kv < 0 ? 0 : (kv > L - 1 ? L - 1 : kv);
            vreg[i] = *(const u32x4*)(VA + (rowb + (size_t)((kv << shift) + r)) * 512 + h * 64 + ch * 8); }
        f32x16 p0;
#pragma unroll
        for (int q = 0; q < 16; ++q) p0[q] = 0.f;
#pragma unroll
        for (int d = 0; d < 4; ++d) p0 = __builtin_amdgcn_mfma_f32_32x32x16_bf16(kf[d], qf[d], p0, 0, 0, 0);
        const int ql = l0 + r32;
#pragma unroll
        for (int q = 0; q < 16; ++q) { const int klr = kl0 + (q & 3) + 8 * (q >> 2) + 4 * hi, df = klr - ql; const bool ok = klr >= 0 && klr < L && df <= 64 && df >= -64; p0[q] = ok ? p0[q] : -INFINITY; }
        float mx = p0[0];
#pragma unroll
        for (int q = 1; q < 16; ++q) mx = fmaxf(mx, p0[q]);
        mx = fmaxf(mx, __shfl_xor(mx, 32));
        const float mn = fmaxf(m, mx), al = fexp2(m - mn); m = mn;
        float rs = 0.f;
#pragma unroll
        for (int q = 0; q < 16; ++q) { p0[q] = fexp2(p0[q] - mn); rs += p0[q]; }
        lsum = lsum * al + rs;
#pragma unroll
        for (int d = 0; d < 2; ++d)
#pragma unroll
            for (int q = 0; q < 16; ++q) O[d][q] *= al;
        bf16x8 pf[2]; pf[0] = packp(p0, 0); pf[1] = packp(p0, 8);
#pragma unroll
        for (int i = 0; i < 4; ++i) { const int id = lane + 64 * i; *(LAS u32x4*)(wl + (id >> 3) * VS * 2 + (id & 7) * 16) = vreg[i]; }
        const LAS unsigned char* vb = wl + vboff;
#pragma unroll
        for (int d = 0; d < 2; ++d)
#pragma unroll
            for (int s = 0; s < 2; ++s) {
                const bf16x8 vf = tr2(vb + (16 * s) * VS * 2 + d * 64, vb + (16 * s + 8) * VS * 2 + d * 64);
                O[d] = __builtin_amdgcn_mfma_f32_32x32x16_bf16(vf, pf[s], O[d], 0, 0, 0);
            }
    }
    const float l = lsum + __shfl_xor(lsum, 32), inv = 1.f / l;
    bf16_t* orow = OAp + (rowb + tq) * 512 + h * 64 + 4 * hi;
#pragma unroll
    for (int d = 0; d < 2; ++d)
#pragma unroll
        for (int g = 0; g < 4; ++g) { u32x2v w; w.x = cvt_pk(O[d][4 * g] * inv, O[d][4 * g + 1] * inv); w.y = cvt_pk(O[d][4 * g + 2] * inv, O[d][4 * g + 3] * inv); *(u32x2v*)(orow + 32 * d + 8 * g) = w; }
    if (hi == 0) LSEp[(rowb + tq) * 8 + h] = m + __log2f(l);
}

struct Args {
    const float* x; const float* p; const int* pos;
    const float *ab_w_in, *ab_q_norm, *ab_w_q_up, *ab_kv_norm, *ab_w_kv_up, *ab_w_out;
    const float *c_w_qkv, *c_lambda, *c_subln, *c_w_out;
    const float *ln_mix_g, *ln_mix_b, *ffn_w_gate, *ffn_w_up, *ffn_conv_w, *ffn_conv_b, *ffn_w_down, *ln_ffn_g, *ln_ffn_b, *ple_w_gate, *ple_w_proj;
    float* out; unsigned char* ws;
};

#ifndef PHM
#define PHM 0xFFFFFFFF
#endif
#define PH(k) if ((PHM >> (k)) & 1)
#define FRESH() int tid = threadIdx.x; asm volatile("" : "+v"(tid)); const int lane = tid & 63, wave = __builtin_amdgcn_readfirstlane(tid >> 6); \
    unsigned char* ws0_ = a.ws; asm volatile("" : "+s"(ws0_)); unsigned char* ws = (unsigned char*)(__attribute__((address_space(1))) unsigned char*)ws0_; \
    float* xf0_ = a.out; asm volatile("" : "+s"(xf0_)); float* XF = (float*)(__attribute__((address_space(1))) float*)xf0_; \
    const int G = gridDim.x, bx = blockIdx.x, vcu = (G % 8 == 0) ? (bx % 8) * (G / 8) + bx / 8 : bx, gw = vcu * 8 + wave, NGW = G * 8; \
    (void)lane; (void)gw; (void)NGW; (void)XF; (void)ws
#define WSP(T, off) ((T*)(ws + (off)))
__global__ void __launch_bounds__(512) fwd_megakernel(Args a) {
    extern __shared__ __attribute__((aligned(16))) unsigned char lds_raw[];
    LAS unsigned char* lds = (LAS unsigned char*)lds_raw;
    cg::grid_group grid = cg::this_grid();

    PH(0) {
        FRESH();
        const int gt = bx * 512 + tid, NTH = G * 512;
        LAS float* scr = (LAS float*)(lds + wave * 16384);
        prep_weight(a.ab_w_in, 1024, 2208, WSP(bf16_t, WS_W_IN), 2304, MapWin{}, scr, gw, NGW, lane);
        prep_weight(a.ab_w_q_up, 384, 768, WSP(bf16_t, WS_W_QUP), 768, MapQup{}, scr, gw, NGW, lane);
        prep_weight(a.ab_w_kv_up, 256, 1024, WSP(bf16_t, WS_W_KVUP), 1024, MapKvup{}, scr, gw, NGW, lane);
        prep_weight(a.ab_w_out, 1024, 1024, WSP(bf16_t, WS_W_OUT0), 1024, MapId{}, scr, gw, NGW, lane);
        prep_weight(a.c_w_out, 1024, 1024, WSP(bf16_t, WS_W_OUT1), 1024, MapId{}, scr, gw, NGW, lane);
        prep_weight(a.c_w_qkv, 1024, 3072, WSP(bf16_t, WS_W_CQKV), 3072, MapRope64{2048}, scr, gw, NGW, lane);
        for (int l = 0; l < 2; ++l) {
            prep_weight(a.ffn_w_gate + (size_t)l * 1024 * DFF, 1024, DFF, WSP(bf16_t, WS_W_GATE) + (size_t)l * DFF * 1024, DFF, MapId{}, scr, gw, NGW, lane);
            prep_weight(a.ffn_w_up + (size_t)l * 1024 * DFF, 1024, DFF, WSP(bf16_t, WS_W_UP) + (size_t)l * DFF * 1024, DFF, MapId{}, scr, gw, NGW, lane);
            prep_weight(a.ffn_w_down + (size_t)l * DFF * 1024, DFF, 1024, WSP(bf16_t, WS_W_DOWN) + (size_t)l * 1024 * DFF, 1024, MapId{}, scr, gw, NGW, lane);
            prep_weight(a.ple_w_gate + (size_t)l * 1024 * 1024, 1024, 1024, WSP(bf16_t, WS_W_PG) + (size_t)l * 1024 * 1024, 1024, MapId{}, scr, gw, NGW, lane);
            prep_weight(a.ple_w_proj + (size_t)l * 256 * 1024, 256, 1024, WSP(bf16_t, WS_W_PP) + (size_t)l * 1024 * 256, 1024, MapId{}, scr, gw, NGW, lane);
        }
        float* ropeA = WSP(float, WS_ROPEA); float* ropeB = WSP(float, WS_ROPEB);
        for (int idx = gt; idx < M * 24; idx += NTH) {
            const int row = idx / 24, j = idx % 24; const float pos = (float)a.pos[row];
            if (j < 8) { const float inv = 1.0f / powf(500000.0f, (float)j * 0.125f), ang = pos * inv; ropeA[(size_t)row * 16 + 2 * j] = cosf(ang); ropeA[(size_t)row * 16 + 2 * j + 1] = sinf(ang); }
            else { const int i = j - 8; const float inv = 1.0f / powf(500000.0f, (float)i * 0.0625f), ang = pos * inv; ropeB[(size_t)row * 32 + 2 * i] = cosf(ang); ropeB[(size_t)row * 32 + 2 * i + 1] = sinf(ang); }
        }
        u32x4* XB4 = WSP(u32x4, WS_XB); u32x4* PB4 = WSP(u32x4, WS_PB);
        for (int i = gt; i < M * DM / 8; i += NTH) { const f32x4 v0 = ((const f32x4*)a.x)[2 * i], v1 = ((const f32x4*)a.x)[2 * i + 1]; XB4[i] = pack8(v0, v1); }
        for (int i = gt; i < 2 * M * 256 / 8; i += NTH) { const f32x4 v0 = ((const f32x4*)a.p)[2 * i], v1 = ((const f32x4*)a.p)[2 * i + 1]; PB4[i] = pack8(v0, v1); }
    }
    grid.sync();

    for (int layer = 0; layer < 2; ++layer) {
        if (layer == 0) {
            PH(1) { FRESH(); run_gemm(lds, WSP(bf16_t, WS_XB), WSP(bf16_t, WS_W_IN), 2304, 1024, G,
                        FWin{WSP(bf16_t, WS_QA), WSP(bf16_t, WS_KA), WSP(bf16_t, WS_VA), WSP(float, WS_LAT), WSP(bf16_t, WS_KB), WSP(float, WS_ROPEA), WSP(float, WS_ROPEB)}); }
            grid.sync();
            PH(2) { FRESH(); unsigned char* dos = (unsigned char*)XF; latnorm_phase(WSP(float, WS_LAT), (bf16_t*)(dos + DO_CQN), (bf16_t*)(dos + DO_CKVN), a.ab_q_norm, a.ab_kv_norm, gw, NGW, lane); }
            grid.sync();
            PH(3) { FRESH(); unsigned char* dos = (unsigned char*)XF; run_gemm(lds, (bf16_t*)(dos + DO_CQN), WSP(bf16_t, WS_W_QUP), 768, 384, G, FQup{(bf16_t*)(dos + DO_QB), WSP(float, WS_ROPEB)}); }
            PH(4) { FRESH(); unsigned char* dos = (unsigned char*)XF; run_gemm(lds, (bf16_t*)(dos + DO_CKVN), WSP(bf16_t, WS_W_KVUP), 1024, 256, G, FKvup{WSP(bf16_t, WS_KB), (bf16_t*)(dos + DO_VB)}); }
            grid.sync();
            PH(5) {
                FRESH(); unsigned char* dos = (unsigned char*)XF;
                const bf16_t* QB = (const bf16_t*)(dos + DO_QB); const bf16_t* VB = (const bf16_t*)(dos + DO_VB); const bf16_t* KB = WSP(bf16_t, WS_KB); bf16_t* MIX = WSP(bf16_t, WS_MIX);
                constexpr int NU = BATCH * 8 * 8; const int upc = (NU + G - 1) / G;
                for (int u = vcu * upc; u < NU && u < (vcu + 1) * upc; ++u) {
                    const int bh = u >> 3, qb = u & 7, b = bh >> 3, h = bh & 7;
                    attn_dense_unit<96, 64>(lds, QB + ((size_t)b * SEQ + qb * 256) * 768 + h * 96, 768, KB + (size_t)b * SEQ * 768 + h * 96, 768,
                                            VB + (size_t)b * SEQ * 512 + h * 64, 512, MIX + ((size_t)b * SEQ + qb * 256) * 1024 + 512 + h * 64, 1024, tid);
                }
            }
            PH(6) {
                FRESH();
                constexpr int NDU = BATCH * 8 * 3 * 64;
                LAS unsigned char* wl = lds + wave * 8192;
                for (int u = gw; u < NDU; u += NGW) {
                    const int lbr = u & 63, rest = u >> 6, pt = rest % 3, bh = rest / 3, b = bh >> 3, h = bh & 7, shift = 2 * pt;
                    const int r = lbr >> (6 - shift), lb = lbr & ((64 >> shift) - 1);
                    attn_dilated_unit(wl, WSP(bf16_t, WS_QA), WSP(bf16_t, WS_KA), WSP(bf16_t, WS_VA), WSP(bf16_t, WS_OA) + (size_t)pt * M * 512, WSP(float, WS_LSE) + (size_t)pt * M * 8, b, h, shift, r, lb, lane);
                }
            }
            grid.sync();
            PH(7) { FRESH(); merge_phase(WSP(bf16_t, WS_OA), WSP(float, WS_LSE), WSP(bf16_t, WS_MIX), gw, NGW, lane); }
            grid.sync();
            PH(8) { FRESH(); run_gemm(lds, WSP(bf16_t, WS_MIX), WSP(bf16_t, WS_W_OUT0), 1024, 1024, G, FResid{a.x, XF}); }
            grid.sync();
        } else {
            PH(9) { FRESH(); run_gemm(lds, WSP(bf16_t, WS_XB2), WSP(bf16_t, WS_W_CQKV), 3072, 1024, G, FCqkv{WSP(bf16_t, WS_QC), WSP(bf16_t, WS_KC), WSP(bf16_t, WS_VC), WSP(float, WS_ROPEA)}); }
            grid.sync();
            PH(10) {
                FRESH();
                const bf16_t* QC = WSP(bf16_t, WS_QC); const bf16_t* KC = WSP(bf16_t, WS_KC); const bf16_t* VC = WSP(bf16_t, WS_VC); bf16_t* O01 = WSP(bf16_t, WS_O01);
                constexpr int NU = BATCH * 16 * 8; const int upc = (NU + G - 1) / G;
                for (int u = vcu * upc; u < NU && u < (vcu + 1) * upc; ++u) {
                    const int bh = u >> 3, qb = u & 7, b = bh >> 4, hh = bh & 15;
                    attn_dense_unit<64, 128>(lds, QC + ((size_t)b * SEQ + qb * 256) * 1024 + hh * 64, 1024, KC + (size_t)b * SEQ * 1024 + hh * 64, 1024,
                                             VC + (size_t)b * SEQ * 1024 + (hh >> 1) * 128, 1024, O01 + ((size_t)b * SEQ + qb * 256) * 2048 + hh * 128, 2048, tid);
                }
            }
            grid.sync();
            PH(11) { FRESH(); diffcomb_phase(WSP(bf16_t, WS_O01), WSP(bf16_t, WS_MIX), a.c_lambda, a.c_subln, gw, NGW, lane); }
            grid.sync();
            PH(12) { FRESH(); run_gemm(lds, WSP(bf16_t, WS_MIX), WSP(bf16_t, WS_W_OUT1), 1024, 1024, G, FResid{XF, XF}); }
            grid.sync();
        }
        PH(13) { FRESH(); ln_phase(XF, WSP(bf16_t, WS_XB), a.ln_mix_g + layer * DM, a.ln_mix_b + layer * DM, gw, NGW, lane); }
        grid.sync();
        PH(14) { FRESH(); run_gemm(lds, WSP(bf16_t, WS_XB), WSP(bf16_t, WS_W_GATE) + (size_t)layer * DFF * 1024, DFF, 1024, G, FBf16{WSP(bf16_t, WS_FA), DFF}); }
        grid.sync();
        PH(15) { FRESH(); run_gemm(lds, WSP(bf16_t, WS_XB), WSP(bf16_t, WS_W_UP) + (size_t)layer * DFF * 1024, DFF, 1024, G,
                     FUpConv{WSP(bf16_t, WS_FA), WSP(bf16_t, WS_FG), a.ffn_conv_w + (size_t)layer * 3 * DFF, a.ffn_conv_b + (size_t)layer * DFF}); }
        grid.sync();
        PH(16) { FRESH(); run_gemm(lds, WSP(bf16_t, WS_FG), WSP(bf16_t, WS_W_DOWN) + (size_t)layer * 1024 * DFF, 1024, DFF, G, FResid{XF, XF}); }
        PH(17) { FRESH(); run_gemm(lds, WSP(bf16_t, WS_PB) + (size_t)layer * M * 256, WSP(bf16_t, WS_W_PP) + (size_t)layer * 1024 * 256, 1024, 256, G, FBf16{WSP(bf16_t, WS_PJ), 1024}); }
        grid.sync();
        PH(18) { FRESH(); ln_phase(XF, WSP(bf16_t, WS_XB), a.ln_ffn_g + layer * DM, a.ln_ffn_b + layer * DM, gw, NGW, lane); }
        grid.sync();
        PH(19) { FRESH(); run_gemm(lds, WSP(bf16_t, WS_XB), WSP(bf16_t, WS_W_PG) + (size_t)layer * 1024 * 1024, 1024, 1024, G, FPle{XF, WSP(bf16_t, WS_PJ), WSP(bf16_t, WS_XB2)}); }
        grid.sync();
    }
}

extern "C" void kernel_launch(void* const* d_in, const int* in_sizes, int n_in, void* d_out, int out_size, void* d_ws, size_t ws_size, hipStream_t stream) {
    static int grid = 0;
    if (grid == 0) {
        if (n_in != 24 || out_size != M * DM || ws_size < WS_NEED) { fprintf(stderr, "kernel_launch: unexpected shapes (n_in %d out %d ws %zu)\n", n_in, out_size, ws_size); grid = -1; return; }
        int dev = 0, cus = 0, per_cu = 0;
        hipGetDevice(&dev); hipDeviceGetAttribute(&cus, hipDeviceAttributeMultiprocessorCount, dev);
        hipFuncSetAttribute((const void*)fwd_megakernel, hipFuncAttributeMaxDynamicSharedMemorySize, LDS_BYTES);
        hipOccupancyMaxActiveBlocksPerMultiprocessor(&per_cu, (const void*)fwd_megakernel, 512, LDS_BYTES);
        if (per_cu < 1) { fprintf(stderr, "kernel_launch: occupancy query says %d blocks per CU\n", per_cu); per_cu = 1; }
        grid = cus;
        (void)hipGetLastError();
    }
    if (grid < 0) return;
    Args a{};
    a.x = (const float*)d_in[0]; a.p = (const float*)d_in[1]; a.pos = (const int*)d_in[2];
    a.ab_w_in = (const float*)d_in[3]; a.ab_q_norm = (const float*)d_in[4]; a.ab_w_q_up = (const float*)d_in[5]; a.ab_kv_norm = (const float*)d_in[6];
    a.ab_w_kv_up = (const float*)d_in[7]; a.ab_w_out = (const float*)d_in[8]; a.c_w_qkv = (const float*)d_in[9]; a.c_lambda = (const float*)d_in[10];
    a.c_subln = (const float*)d_in[11]; a.c_w_out = (const float*)d_in[12]; a.ln_mix_g = (const float*)d_in[13]; a.ln_mix_b = (const float*)d_in[14];
    a.ffn_w_gate = (const float*)d_in[15]; a.ffn_w_up = (const float*)d_in[16]; a.ffn_conv_w = (const float*)d_in[17]; a.ffn_conv_b = (const float*)d_in[18];
    a.ffn_w_down = (const float*)d_in[19]; a.ln_ffn_g = (const float*)d_in[20]; a.ln_ffn_b = (const float*)d_in[21]; a.ple_w_gate = (const float*)d_in[22]; a.ple_w_proj = (const float*)d_in[23];
    a.out = (float*)d_out; a.ws = (unsigned char*)d_ws;
    void* args[] = {&a};
    hipError_t e = hipLaunchCooperativeKernel((const void*)fwd_megakernel, dim3(grid), dim3(512), args, LDS_BYTES, stream);
    if (e != hipSuccess) fprintf(stderr, "kernel_launch: cooperative launch failed: %s (grid %d)\n", hipGetErrorString(e), grid);
}
```

```cpp
#include <hip/hip_runtime.h>
#include <hip/hip_cooperative_groups.h>
#include <cstdio>
#include <cstdint>
namespace cg = cooperative_groups;
namespace pg8 {
#define PG8_LAS __attribute__((address_space(3)))
typedef unsigned short bf16_t;
typedef short bf16x8 __attribute__((ext_vector_type(8)));
typedef float f32x4 __attribute__((ext_vector_type(4)));
typedef unsigned u32x4 __attribute__((ext_vector_type(4)));
constexpr int BM = 256, BK = 64, HALF = 128, HTB = HALF * BK * 2  , STAGE_BYTES = 8 * HTB, NXCD = 8, WGM = 8;

__host__ __device__ __forceinline__ int lds_byte(int r, int c) { const int st = (r >> 4) * 2 + (c >> 5), rr = r & 15, cc = c & 31, ob = rr * 64 + cc * 2; return st * 1024 + (ob ^ (((ob >> 9) & 1) << 5)); }
__host__ __device__ __forceinline__ void stage_rc(int b, int& R, int& C) { const int st = b / 1024, sb = b % 1024, swz = sb ^ (((sb >> 9) & 1) << 5); R = (st >> 1) * 16 + swz / 64; C = (st & 1) * 32 + (swz % 64) / 2; }
__host__ __device__ __forceinline__ int perm32(int rho) { const int n = rho >> 4, i = rho & 15; return 8 * (i >> 2) + 4 * n + (i & 3); }

struct Unit { int pm, pn; };
struct Gemm { const bf16_t* A; const bf16_t* Bt; int M, N, K; };

struct StaticOrder {
    int nM, nN, nwg, G, c;
    __host__ __device__ void init(int M, int N, int G_, int c_) { nM = M / BM; nN = N / BM; nwg = nM * nN; G = G_; c = c_; }
    __host__ __device__ bool next(int i, Unit& u) const {
        const long L = (long)i * G + c; if (L >= nwg) return false;
        int wgid = (int)L; { const int q = nwg / NXCD, r = nwg % NXCD, xcd = wgid % NXCD, off = wgid / NXCD; wgid = (xcd < r ? xcd * (q + 1) : r * (q + 1) + (xcd - r) * q) + off; }
        const int nig = WGM * nN, gid = wgid / nig, fm = gid * WGM, gsz = (nM - fm) < WGM ? (nM - fm) : WGM;
        u.pm = fm + ((wgid % nig) % gsz); u.pn = (wgid % nig) / gsz; return true;
    }
    __device__ __forceinline__ void a_ready(const Unit&) const {}
    __device__ __forceinline__ void done(const Unit&) const {}
};

__device__ __forceinline__ unsigned cvt_pk_bf16(float lo, float hi) { unsigned r; asm volatile("v_cvt_pk_bf16_f32 %0, %1, %2" : "=v"(r) : "v"(lo), "v"(hi)); return r; }
template <class Epi, class Sched, bool ALIGN_EPI = false, bool SP2 = false>
__device__ __forceinline__ void gemm_phase(PG8_LAS unsigned char* lds, const Gemm g, const Sched& S, const Epi& E) {
    int tid = threadIdx.x; asm volatile("" : "+v"(tid));
    const int wid = __builtin_amdgcn_readfirstlane(tid >> 6), lane = tid & 63, wr = wid >> 2, wc = wid & 3, fr = lane & 15, fq = lane >> 4;
    const int K = g.K, nt = K / BK;
    unsigned voffA[2], voffB[2];
#pragma unroll
    for (int i = 0; i < 2; ++i) { int R, C; stage_rc(tid * 16 + i * 8192, R, C); const int Rb = Epi::PERM ? ((R & ~31) + perm32(R & 31)) : R;
        voffA[i] = (unsigned)(R * K + C) * 2u; voffB[i] = (unsigned)(Rb * K + C) * 2u; }
    const size_t kstep = (size_t)(BK * 2);
    const size_t hstep = (size_t)HALF * K * 2;
    const size_t tstep = 2 * hstep;
    const unsigned ldsw = (unsigned)wid * 1024u;
    const int aoff = lds_byte(wr * 64 + fr, fq * 8), boff = lds_byte(wc * 32 + fr, fq * 8);
#define PG8_SA(b, h) (((b) * 2 + (h)) * HTB)
#define PG8_SB(b, h) ((4 + (b) * 2 + (h)) * HTB)
#define PG8_STAGE(bufoff, gbase, voff) do { _Pragma("unroll") for (int _i = 0; _i < 2; ++_i) \
        __builtin_amdgcn_global_load_lds((const unsigned*)((const char*)(gbase) + (voff)[_i]), (PG8_LAS unsigned*)(lds + (bufoff) + ldsw + _i * 8192), 16, 0, 0); } while (0)
#define PG8_LDA(dst, b, h) do { _Pragma("unroll") for (int m = 0; m < 4; ++m) _Pragma("unroll") for (int k = 0; k < 2; ++k) dst[m][k] = *(const PG8_LAS bf16x8*)(lds + PG8_SA(b, h) + aoff + m * 2048 + k * 1024); } while (0)
#define PG8_LDB(dst, b, h) do { _Pragma("unroll") for (int n = 0; n < 2; ++n) _Pragma("unroll") for (int k = 0; k < 2; ++k) dst[n][k] = *(const PG8_LAS bf16x8*)(lds + PG8_SB(b, h) + boff + n * 2048 + k * 1024); } while (0)
#define PG8_MMA(ai, bj, At, Bt) do { __builtin_amdgcn_s_setprio(1); _Pragma("unroll") for (int m = 0; m < 4; ++m) _Pragma("unroll") for (int n = 0; n < 2; ++n) _Pragma("unroll") for (int k = 0; k < 2; ++k) \
        acc[ai][bj][m][n] = __builtin_amdgcn_mfma_f32_16x16x32_bf16(Bt[n][k], At[m][k], acc[ai][bj][m][n], 0, 0, 0); __builtin_amdgcn_s_setprio(0); } while (0)
#define PG8_WAIT_V(n) asm volatile("s_waitcnt vmcnt(" #n ")" ::: "memory")
#define PG8_WAIT_L(n) asm volatile("s_waitcnt lgkmcnt(" #n ")" ::: "memory")
#define PG8_BAR __builtin_amdgcn_s_barrier()
#define PG8_SCHED __builtin_amdgcn_sched_barrier(0)
    Unit cur, nxt; int ui = 0;
    if (!S.next(0, cur)) return;
    f32x4 acc[2][2][4][2];
#pragma unroll
    for (int a = 0; a < 2; ++a)
#pragma unroll
        for (int b = 0; b < 2; ++b)
#pragma unroll
            for (int m = 0; m < 4; ++m)
#pragma unroll
                for (int n = 0; n < 2; ++n) acc[a][b][m][n] = (f32x4){0.f, 0.f, 0.f, 0.f};
    bf16x8 At[4][2], B0[2][2], B1[2][2];
    const char* cA = (const char*)g.A + (size_t)cur.pm * tstep; const char* cB = (const char*)g.Bt + (size_t)cur.pn * tstep;
    S.a_ready(cur);
    if constexpr (SP2) {
        PG8_STAGE(PG8_SB(0, 0), cB, voffB); PG8_STAGE(PG8_SB(0, 1), cB + hstep, voffB); PG8_STAGE(PG8_SA(0, 0), cA, voffA); PG8_STAGE(PG8_SA(0, 1), cA + hstep, voffA);
        if (wr == 1) PG8_BAR;
        PG8_WAIT_V(2); PG8_BAR;
        PG8_STAGE(PG8_SB(1, 0), cB + kstep, voffB); PG8_STAGE(PG8_SA(1, 0), cA + kstep, voffA); PG8_STAGE(PG8_SB(1, 1), cB + hstep + kstep, voffB);
        PG8_WAIT_V(6); PG8_BAR;
    } else {
        PG8_STAGE(PG8_SB(0, 0), cB, voffB); PG8_STAGE(PG8_SA(0, 0), cA, voffA); PG8_STAGE(PG8_SB(0, 1), cB + hstep, voffB); PG8_STAGE(PG8_SA(0, 1), cA + hstep, voffA);
        if (wr == 1) PG8_BAR;
        PG8_WAIT_V(4); PG8_BAR;
        PG8_STAGE(PG8_SB(1, 0), cB + kstep, voffB); PG8_STAGE(PG8_SA(1, 0), cA + kstep, voffA); PG8_STAGE(PG8_SB(1, 1), cB + hstep + kstep, voffB);
        PG8_WAIT_V(6); PG8_BAR;
    }
    for (;;) {
        const bool has_next = S.next(ui + 1, nxt);
        const char* nA = has_next ? (const char*)g.A + (size_t)nxt.pm * tstep : cA; const char* nB = has_next ? (const char*)g.Bt + (size_t)nxt.pn * tstep : cB;
#pragma nounroll
        for (int t = 0; t < nt; t += 2) {
            const bool last = (t == nt - 2);
            const char* a1 = cA + (size_t)(t + 1) * kstep;
            const char* a2 = last ? nA : cA + (size_t)(t + 2) * kstep; const char* b2 = last ? nB : cB + (size_t)(t + 2) * kstep;
            const char* a3 = a2 + kstep; const char* b3 = b2 + kstep;
            if (last && has_next) S.a_ready(nxt);
            if constexpr (SP2) {
            PG8_LDB(B0, 0, 0); PG8_LDB(B1, 0, 1); PG8_SCHED; PG8_LDA(At, 0, 0); PG8_STAGE(PG8_SA(1, 1), a1 + hstep, voffA);
            PG8_WAIT_V(8); PG8_WAIT_L(0); PG8_BAR; PG8_MMA(0, 0, At, B0); PG8_MMA(0, 1, At, B1); PG8_BAR; PG8_SCHED;
            PG8_LDA(At, 0, 1); PG8_STAGE(PG8_SB(0, 0), b2, voffB); PG8_STAGE(PG8_SB(0, 1), b2 + hstep, voffB); PG8_STAGE(PG8_SA(0, 0), a2, voffA);
            PG8_WAIT_V(8); PG8_WAIT_L(0); PG8_BAR; PG8_MMA(1, 0, At, B0); PG8_MMA(1, 1, At, B1); PG8_BAR; PG8_SCHED;
            PG8_LDB(B0, 1, 0); PG8_LDB(B1, 1, 1); PG8_SCHED; PG8_LDA(At, 1, 0); PG8_STAGE(PG8_SA(0, 1), a2 + hstep, voffA);
            PG8_WAIT_V(8); PG8_WAIT_L(0); PG8_BAR; PG8_MMA(0, 0, At, B0); PG8_MMA(0, 1, At, B1); PG8_BAR; PG8_SCHED;
            PG8_LDA(At, 1, 1); PG8_STAGE(PG8_SB(1, 0), b3, voffB); PG8_STAGE(PG8_SB(1, 1), b3 + hstep, voffB); PG8_STAGE(PG8_SA(1, 0), a3, voffA);
            PG8_WAIT_V(8); PG8_WAIT_L(0); PG8_BAR; PG8_MMA(1, 0, At, B0); PG8_MMA(1, 1, At, B1); PG8_BAR; PG8_SCHED;
            } else {
            PG8_LDB(B0, 0, 0); PG8_SCHED; PG8_LDA(At, 0, 0); PG8_STAGE(PG8_SA(1, 1), a1 + hstep, voffA);
            PG8_WAIT_L(8); PG8_BAR; PG8_WAIT_L(0); PG8_MMA(0, 0, At, B0); PG8_BAR; PG8_SCHED;
            PG8_LDB(B1, 0, 1); PG8_STAGE(PG8_SB(0, 0), b2, voffB);
            PG8_BAR; PG8_WAIT_L(0); PG8_MMA(0, 1, At, B1); PG8_BAR;
            PG8_LDA(At, 0, 1); PG8_STAGE(PG8_SA(0, 0), a2, voffA);
            PG8_BAR; PG8_WAIT_L(0); PG8_MMA(1, 0, At, B0); PG8_BAR; PG8_SCHED;
            PG8_STAGE(PG8_SB(0, 1), b2 + hstep, voffB);
            PG8_WAIT_V(6); PG8_BAR; PG8_MMA(1, 1, At, B1); PG8_BAR;
            PG8_LDB(B0, 1, 0); PG8_SCHED; PG8_LDA(At, 1, 0); PG8_STAGE(PG8_SA(0, 1), a2 + hstep, voffA);
            PG8_WAIT_L(8); PG8_BAR; PG8_WAIT_L(0); PG8_MMA(0, 0, At, B0); PG8_BAR; PG8_SCHED;
            PG8_LDB(B1, 1, 1); PG8_STAGE(PG8_SB(1, 0), b3, voffB);
            PG8_BAR; PG8_WAIT_L(0); PG8_MMA(0, 1, At, B1); PG8_BAR;
            PG8_LDA(At, 1, 1); PG8_STAGE(PG8_SA(1, 0), a3, voffA);
            PG8_BAR; PG8_WAIT_L(0); PG8_MMA(1, 0, At, B0); PG8_BAR; PG8_SCHED;
            PG8_STAGE(PG8_SB(1, 1), b3 + hstep, voffB);
            PG8_WAIT_V(6); PG8_BAR; PG8_MMA(1, 1, At, B1); PG8_BAR;
            }
        }
        if constexpr (ALIGN_EPI) { if (wr == 0) PG8_BAR; }
        if constexpr (!Epi::AFTER_DRAIN) { E(acc, cur, wr, wc, fr, fq); S.done(cur); }
        if (!has_next) break;
#pragma unroll
        for (int a = 0; a < 2; ++a)
#pragma unroll
            for (int b = 0; b < 2; ++b)
#pragma unroll
                for (int m = 0; m < 4; ++m)
#pragma unroll
                    for (int n = 0; n < 2; ++n) acc[a][b][m][n] = (f32x4){0.f, 0.f, 0.f, 0.f};
        cur = nxt; cA = nA; cB = nB; ++ui;
        if constexpr (ALIGN_EPI) { if (wr == 1) PG8_BAR; }
    }
    PG8_WAIT_V(0);
    if constexpr (!ALIGN_EPI) { if (wr == 0) PG8_BAR; }
    PG8_BAR;
    if constexpr (Epi::AFTER_DRAIN) { E.fused(acc, cur, wr, wc, fr, fq, lds, wid, lane); S.done(cur); }
#undef PG8_SA
#undef PG8_SB
#undef PG8_STAGE
#undef PG8_LDA
#undef PG8_LDB
#undef PG8_MMA
#undef PG8_WAIT_V
#undef PG8_WAIT_L
#undef PG8_BAR
#undef PG8_SCHED
}
}

#define LAS __attribute__((address_space(3)))
#define GAS __attribute__((address_space(1)))
using pg8::bf16_t; using pg8::bf16x8; using pg8::f32x4; using pg8::u32x4;
typedef float f32x16 __attribute__((ext_vector_type(16)));
typedef float f32x2v __attribute__((ext_vector_type(2)));
typedef unsigned u32x2v __attribute__((ext_vector_type(2)));
typedef short v4i16_t __attribute__((ext_vector_type(4)));
constexpr int BATCH = 16, SEQ = 2048, DM = 1024, M = BATCH * SEQ, DFF = 2816;
constexpr float ALPHA = 1.41421356237309515f, LOG2E = 1.4426950408889634f;
constexpr float QS_A = 0.125f * LOG2E, QS_B = 0.10206207261596577f * LOG2E, QS_C = 0.125f * LOG2E;
constexpr float LAMBDA_INIT = 0.8f - 0.6f * 0.74081822068171788f;
constexpr float NEG_BIG = -1e30f;
constexpr size_t MiB = (size_t)1 << 20;
constexpr size_t WS_W_IN = 1 * MiB;
constexpr size_t WS_W_QUP = WS_W_IN + (size_t)2304 * 1024 * 2;
constexpr size_t WS_W_KVUP = WS_W_QUP + (size_t)768 * 384 * 2;
constexpr size_t WS_W_OUT0 = WS_W_KVUP + (size_t)1024 * 256 * 2;
constexpr size_t WS_W_OUT1 = WS_W_OUT0 + 2 * MiB;
constexpr size_t WS_W_CQKV = WS_W_OUT1 + 2 * MiB;
constexpr size_t WS_W_GATE = WS_W_CQKV + 6 * MiB;
constexpr size_t WSZ_FF = (size_t)2816 * 1024 * 2;
constexpr size_t WS_W_UP = WS_W_GATE + 2 * WSZ_FF;
constexpr size_t WS_W_DOWN = WS_W_UP + 2 * WSZ_FF;
constexpr size_t WS_W_PG = WS_W_DOWN + 2 * WSZ_FF;
constexpr size_t WS_W_PP = WS_W_PG + 4 * MiB;
constexpr size_t WS_W_END = WS_W_PP + 2 * (size_t)1024 * 256 * 2;
static_assert(WS_W_END <= 58 * MiB, "weights region");
constexpr size_t WS_VEC = 56 * MiB;
constexpr int VEC_L = 13312, V_CSG = 0, V_BWG = 2816, V_CSU = 5632, V_BWU = 8448, V_CSP = 11264, V_BWP = 12288;
constexpr size_t WS_PART = 160 * MiB;
constexpr size_t WS_ST = 57 * MiB;
static_assert(WS_W_END <= WS_VEC, "weights vs vectors");
constexpr size_t WS_ROPEA = 58 * MiB, WS_ROPEB = 60 * MiB;
constexpr size_t WS_XB = 64 * MiB, WS_PB = 128 * MiB, WS_PJ = 160 * MiB, WS_MIX = 160 * MiB;
constexpr size_t WS_QA = 224 * MiB, WS_KA = 256 * MiB, WS_VA = 288 * MiB, WS_KB = 320 * MiB, WS_LAT = 368 * MiB, WS_OA = 368 * MiB, WS_LSE = 464 * MiB;
constexpr size_t DO_CQN = 0, DO_CKVN = 24 * MiB, DO_QB = 40 * MiB, DO_VB = 88 * MiB;
constexpr size_t WS_FA = 160 * MiB, WS_FG = 336 * MiB;
constexpr size_t WS_BA = 160 * MiB, WS_BU = 166 * MiB, WS_BC = 172 * MiB;
constexpr size_t WS_QC = 160 * MiB, WS_KC = 224 * MiB, WS_VC = 288 * MiB, WS_O0 = 352 * MiB, WS_MIX1 = 416 * MiB;
constexpr size_t WS_XB2 = 448 * MiB;
constexpr size_t WS_NEED = 512 * MiB;
constexpr int LDS_BYTES = 131072 + 1024;

#define XB_TMO      128
#define XB_XCNT(j)  (256  + 64 * (j))
#define XB_XSUB(j)  (1280 + 64 * (j))
#define XB_XGEN(j)  (2304 + 64 * (j))
#define XB_TOP      3328
#define XB_TOPGEN   3392
#define XCD_BAR_WORDS 3456
#define XB_SPIN_CAP (1u << 18)

__device__ __forceinline__ unsigned xb_ld(unsigned* p)              { return __hip_atomic_load(p, __ATOMIC_RELAXED, __HIP_MEMORY_SCOPE_AGENT); }
__device__ __forceinline__ unsigned xb_add(unsigned* p, unsigned v) { return __hip_atomic_fetch_add(p, v, __ATOMIC_RELAXED, __HIP_MEMORY_SCOPE_AGENT); }
__device__ __forceinline__ unsigned xb_xcc_id() { return (unsigned)__builtin_amdgcn_s_getreg((3 << 11) | 20) & 0xFu; }
#define XB_SPIN(cond, bar) do { unsigned _sp = 0; while (cond) { __builtin_amdgcn_s_sleep(1); \
    if ((++_sp & 255u) == 0u) { if (xb_ld(&(bar)[XB_TMO])) break; if (_sp > XB_SPIN_CAP) { atomicAdd(&(bar)[XB_TMO], 1u); break; } } } } while (0)

struct XcdBarrier {
    unsigned* bar; unsigned x;
    volatile LAS unsigned* st;
};

__device__ __forceinline__ XcdBarrier xcd_barrier_post(unsigned* bar, volatile LAS unsigned* st) {
    XcdBarrier b; b.bar = bar; b.x = xb_xcc_id(); b.st = st;
    if (threadIdx.x == 0) (void)xb_add(&bar[XB_XCNT(b.x)], 1u);
    return b;
}
__device__ __forceinline__ void xcd_barrier_complete(unsigned* bar, unsigned x, unsigned& nloc, unsigned& nx) {
    const unsigned G = gridDim.x * gridDim.y * gridDim.z;
    unsigned sum, cnt, mine, sp = 0u;
    for (;;) {
        sum = 0u; cnt = 0u; mine = 0u;
#pragma unroll
        for (unsigned j = 0; j < 16; ++j) { const unsigned c = xb_ld(&bar[XB_XCNT(j)]); sum += c; cnt += (c > 0u) ? 1u : 0u; mine = (j == x) ? c : mine; }
        if (sum == G) break;
        __builtin_amdgcn_s_sleep(1);
        if ((++sp & 255u) == 0u) { if (xb_ld(&bar[XB_TMO])) break; if (sp > XB_SPIN_CAP) { atomicAdd(&bar[XB_TMO], 1u); break; } }
    }
    nloc = mine > 0u ? mine : 1u; nx = cnt > 0u ? cnt : 1u;
}

__device__ __forceinline__ void xcd_barrier(const XcdBarrier& b) {
    asm volatile("s_waitcnt vmcnt(0)" ::: "memory");
    __syncthreads();
    if (threadIdx.x == 0) {
        unsigned* bar = b.bar;
        __builtin_amdgcn_s_waitcnt(0);
        unsigned nloc = b.st[0], nx = b.st[1];
        if (nloc == 0u) { xcd_barrier_complete(bar, b.x, nloc, nx); b.st[0] = nloc; b.st[1] = nx; }
        const unsigned old = xb_add(&bar[XB_XSUB(b.x)], 1u);
        const unsigned gen = old / nloc;
        if (old + 1u == (gen + 1u) * nloc) {
            __builtin_amdgcn_fence(__ATOMIC_RELEASE, "agent");
            asm volatile("s_waitcnt vmcnt(0)" ::: "memory");
            const unsigned og = xb_add(&bar[XB_TOP], 1u);
            const unsigned tg = og / nx;
            if (og + 1u == (tg + 1u) * nx) xb_add(&bar[XB_TOPGEN], 1u);
            else XB_SPIN(xb_ld(&bar[XB_TOPGEN]) == tg, bar);
            __builtin_amdgcn_fence(__ATOMIC_ACQUIRE, "agent");
            xb_add(&bar[XB_XGEN(b.x)], 1u);
            asm volatile("s_waitcnt vmcnt(0)" ::: "memory");
        } else {
            XB_SPIN(xb_ld(&bar[XB_XGEN(b.x)]) == gen, bar);
            __builtin_amdgcn_fence(__ATOMIC_ACQUIRE, "agent");
            asm volatile("s_waitcnt vmcnt(0)" ::: "memory");
        }
    }
    __syncthreads();
}

__device__ __forceinline__ unsigned cvt_pk(float lo, float hi) { return pg8::cvt_pk_bf16(lo, hi); }
__device__ __forceinline__ float bf_lo(unsigned w) { return __uint_as_float(w << 16); }
__device__ __forceinline__ float bf_hi(unsigned w) { return __uint_as_float(w & 0xffff0000u); }
__device__ __forceinline__ u32x4 pack8(f32x4 a, f32x4 b) { u32x4 w; w.x = cvt_pk(a[0], a[1]); w.y = cvt_pk(a[2], a[3]); w.z = cvt_pk(b[0], b[1]); w.w = cvt_pk(b[2], b[3]); return w; }
__device__ __forceinline__ void unpack8(u32x4 w, f32x4& a, f32x4& b) { a = (f32x4){bf_lo(w.x), bf_hi(w.x), bf_lo(w.y), bf_hi(w.y)}; b = (f32x4){bf_lo(w.z), bf_hi(w.z), bf_lo(w.w), bf_hi(w.w)}; }
__device__ __forceinline__ float fexp2(float x) { return __builtin_amdgcn_exp2f(x); }
__device__ __forceinline__ float wave_sum(float v) {
#pragma unroll
    for (int o = 1; o < 64; o <<= 1) v += __shfl_xor(v, o);
    return v;
}
__device__ __forceinline__ void rope8(f32x4& v0, f32x4& v1, const float* tab) {
    const f32x4 t0 = *(const f32x4*)tab, t1 = *(const GAS f32x4*)(tab + 4);
    float a, b;
    a = v0[0]; b = v0[1]; v0[0] = a * t0[0] - b * t0[1]; v0[1] = b * t0[0] + a * t0[1];
    a = v0[2]; b = v0[3]; v0[2] = a * t0[2] - b * t0[3]; v0[3] = b * t0[2] + a * t0[3];
    a = v1[0]; b = v1[1]; v1[0] = a * t1[0] - b * t1[1]; v1[1] = b * t1[0] + a * t1[1];
    a = v1[2]; b = v1[3]; v1[2] = a * t1[2] - b * t1[3]; v1[3] = b * t1[2] + a * t1[3];
}

__device__ __forceinline__ void row_stats(const float* st, int row, float& mean, float& rstd) {
    const f32x2v s = *(const GAS f32x2v*)(st + 2 * (size_t)row);
    mean = s[0] * (1.f / DM); const float var = s[1] * (1.f / DM) - mean * mean; rstd = 1.f / sqrtf(fmaxf(var, 0.f) + 1e-5f);
}
struct LnCtx { f32x4 cs[2], bw[2]; };
__device__ __forceinline__ void ln_ctx(const float* cs, const float* bw, int c0, LnCtx& c) {
#pragma unroll
    for (int i = 0; i < 2; ++i) { c.cs[i] = *(const GAS f32x4*)(cs + c0 + 4 * i); c.bw[i] = *(const GAS f32x4*)(bw + c0 + 4 * i); }
}
__device__ __forceinline__ void ln_fix(f32x4& v0, f32x4& v1, float mean, float rstd, const LnCtx& c) {
    v0 = (v0 - c.cs[0] * mean) * rstd + c.bw[0]; v1 = (v1 - c.cs[1] * mean) * rstd + c.bw[1];
}
struct NoCtx {};
template <class F> struct Epi8 {
    static constexpr bool PERM = true, AFTER_DRAIN = false; F f;
    __device__ __forceinline__ void operator()(const f32x4 (&acc)[2][2][4][2], const pg8::Unit& u, int wr, int wc, int fr, int fq) const {
        const int row0 = u.pm * 256 + wr * 64 + fr, col0 = u.pn * 256 + wc * 32 + 8 * fq;
#pragma unroll
        for (int bj = 0; bj < 2; ++bj) {
            const int c0 = col0 + bj * 128; typename F::Ctx ctx; f.prep(c0, ctx);
#pragma unroll
            for (int ai = 0; ai < 2; ++ai)
#pragma unroll
                for (int m0 = 0; m0 < 4; m0 += F::NB) {
                    typename F::Tmp tmp[F::NB];
#pragma unroll
                    for (int m = 0; m < F::NB; ++m) f.load(row0 + ai * 128 + (m0 + m) * 16, c0, tmp[m]);
#pragma unroll
                    for (int m = 0; m < F::NB; ++m) f.apply(row0 + ai * 128 + (m0 + m) * 16, c0, acc[ai][bj][m0 + m][0], acc[ai][bj][m0 + m][1], ctx, tmp[m]);
                    asm volatile("" ::: "memory");
                }
        }
    }
};
struct RopeTmp { f32x4 t0, t1; };
__device__ __forceinline__ void rope8t(f32x4& v0, f32x4& v1, const RopeTmp& t) {
    float a, b;
    a = v0[0]; b = v0[1]; v0[0] = a * t.t0[0] - b * t.t0[1]; v0[1] = b * t.t0[0] + a * t.t0[1];
    a = v0[2]; b = v0[3]; v0[2] = a * t.t0[2] - b * t.t0[3]; v0[3] = b * t.t0[2] + a * t.t0[3];
    a = v1[0]; b = v1[1]; v1[0] = a * t.t1[0] - b * t.t1[1]; v1[1] = b * t.t1[0] + a * t.t1[1];
    a = v1[2]; b = v1[3]; v1[2] = a * t.t1[2] - b * t.t1[3]; v1[3] = b * t.t1[2] + a * t.t1[3];
}
__device__ __forceinline__ void rope_ld(RopeTmp& t, const float* tab) { t.t0 = *(const f32x4*)tab; t.t1 = *(const GAS f32x4*)(tab + 4); }
struct FWin { static constexpr int NB = 4;
    typedef NoCtx Ctx; typedef RopeTmp Tmp; bf16_t *QA, *KA, *VA; float* LAT; bf16_t* KB; const float *ropeA, *ropeB;
    __device__ __forceinline__ void prep(int, Ctx&) const {}
    __device__ __forceinline__ void load(int row, int c0, Tmp& t) const {
        if (c0 < 1024) { if ((c0 & 63) < 16) rope_ld(t, ropeA + (size_t)row * 16 + (c0 & 63)); }
        else if (c0 >= 2176 && c0 < 2208) rope_ld(t, ropeB + (size_t)row * 32 + (c0 - 2176));
    }
    __device__ __forceinline__ void apply(int row, int c0, f32x4 v0, f32x4 v1, const Ctx&, const Tmp& t) const {
        if (c0 < 1536) {
            const int sec = c0 >> 9, cc = c0 & 511;
            if (sec < 2 && (cc & 63) < 16) rope8t(v0, v1, t);
            if (sec == 0) { v0 = v0 * QS_A; v1 = v1 * QS_A; }
            bf16_t* dst = (sec == 0 ? QA : (sec == 1 ? KA : VA)) + (size_t)row * 512 + cc;
            *(u32x4*)dst = pack8(v0, v1);
        } else if (c0 < 2176) {
            float* dst = LAT + (size_t)row * 640 + (c0 - 1536);
            *(f32x4*)dst = v0; *(GAS f32x4*)(dst + 4) = v1;
        } else if (c0 < 2208) {
            const int j = c0 - 2176;
            rope8t(v0, v1, t);
            const u32x4 w = pack8(v0, v1);
            bf16_t* dst = KB + (size_t)row * 768 + 64 + j;
#pragma unroll
            for (int h = 0; h < 8; ++h) *(GAS u32x4*)(dst + h * 96) = w;
        }
    }
};
struct FQup { static constexpr int NB = 4;
    typedef NoCtx Ctx; typedef RopeTmp Tmp; bf16_t* QB; const float* ropeB;
    __device__ __forceinline__ void prep(int, Ctx&) const {}
    __device__ __forceinline__ void load(int row, int c0, Tmp& t) const { const int w = c0 % 96; if (w >= 64) rope_ld(t, ropeB + (size_t)row * 32 + (w - 64)); }
    __device__ __forceinline__ void apply(int row, int c0, f32x4 v0, f32x4 v1, const Ctx&, const Tmp& t) const {
        const int w = c0 % 96;
        if (w >= 64) rope8t(v0, v1, t);
        v0 = v0 * QS_B; v1 = v1 * QS_B;
        *(GAS u32x4*)(QB + (size_t)row * 768 + c0) = pack8(v0, v1);
    }
};
struct FKvup { static constexpr int NB = 4;
    typedef NoCtx Ctx; typedef NoCtx Tmp; bf16_t *KB, *VB;
    __device__ __forceinline__ void prep(int, Ctx&) const {}
    __device__ __forceinline__ void load(int, int, Tmp&) const {}
    __device__ __forceinline__ void apply(int row, int c0, f32x4 v0, f32x4 v1, const Ctx&, const Tmp&) const {
        const u32x4 w = pack8(v0, v1);
        if (c0 < 512) *(GAS u32x4*)(KB + (size_t)row * 768 + (c0 >> 6) * 96 + (c0 & 63)) = w;
        else *(GAS u32x4*)(VB + (size_t)row * 512 + (c0 - 512)) = w;
    }
};
struct FBf16 { static constexpr int NB = 4;
    typedef NoCtx Ctx; typedef NoCtx Tmp; bf16_t* O; int ld;
    __device__ __forceinline__ void prep(int, Ctx&) const {}
    __device__ __forceinline__ void load(int, int, Tmp&) const {}
    __device__ __forceinline__ void apply(int row, int c0, f32x4 v0, f32x4 v1, const Ctx&, const Tmp&) const { *(GAS u32x4*)(O + (size_t)row * ld + c0) = pack8(v0, v1); }
};
__device__ __forceinline__ float gelu_tanh(float c) {
    constexpr float GA = -2.0f * LOG2E * 0.7978845608028654f, GB = GA * 0.044715f;
    return c * __builtin_amdgcn_rcpf(1.0f + fexp2(c * __builtin_fmaf(GB, c * c, GA)));
}
struct StTmp { f32x2v s; };
__device__ __forceinline__ void st_decode(const StTmp& t, float& mean, float& rstd) {
    mean = t.s[0] * (1.f / DM); const float var = t.s[1] * (1.f / DM) - mean * mean; rstd = 1.f / sqrtf(fmaxf(var, 0.f) + 1e-5f);
}
struct FGateLn { static constexpr int NB = 4;
    typedef LnCtx Ctx; typedef StTmp Tmp; bf16_t* O; const float* st; const float* cs; const float* bw;
    __device__ __forceinline__ void prep(int c0, Ctx& c) const { ln_ctx(cs, bw, c0, c); }
    __device__ __forceinline__ void load(int row, int, Tmp& t) const { t.s = *(const GAS f32x2v*)(st + 2 * (size_t)row); }
    __device__ __forceinline__ void apply(int row, int c0, f32x4 v0, f32x4 v1, const Ctx& c, const Tmp& t) const {
        float mean, rstd; st_decode(t, mean, rstd); ln_fix(v0, v1, mean, rstd, c);
        *(GAS u32x4*)(O + (size_t)row * DFF + c0) = pack8(v0, v1);
    }
};
struct FUpConv { static constexpr int NB = 1;
    struct Ctx { f32x4 w0[2], w1[2], w2[2], b[2]; LnCtx ln; };
    struct Tmp { f32x2v s; u32x4 wm, w0, wp; };
    const bf16_t* A; bf16_t* Gout; const float* cw; const float* cb; const float* st; const float* cs; const float* bw;
    __device__ __forceinline__ void prep(int c0, Ctx& c) const {
        ln_ctx(cs, bw, c0, c.ln);
#pragma unroll
        for (int i = 0; i < 2; ++i) { c.w0[i] = *(const GAS f32x4*)(cw + c0 + 4 * i); c.w1[i] = *(const GAS f32x4*)(cw + DFF + c0 + 4 * i); c.w2[i] = *(const GAS f32x4*)(cw + 2 * DFF + c0 + 4 * i); c.b[i] = *(const GAS f32x4*)(cb + c0 + 4 * i); }
    }
    __device__ __forceinline__ void load(int row, int c0, Tmp& t) const {
        const int tt = row & (SEQ - 1);
        const bf16_t* ap = A + (size_t)row * DFF + c0;
        const u32x4 z = (u32x4){0u, 0u, 0u, 0u};
        t.s = *(const GAS f32x2v*)(st + 2 * (size_t)row);
        t.wm = tt > 0 ? *(const GAS u32x4*)(ap - DFF) : z; t.w0 = *(const u32x4*)ap; t.wp = tt < SEQ - 1 ? *(const GAS u32x4*)(ap + DFF) : z;
    }
    __device__ __forceinline__ void apply(int row, int c0, f32x4 v0, f32x4 v1, const Ctx& c, const Tmp& t) const {
        { StTmp s{t.s}; float mean, rstd; st_decode(s, mean, rstd); ln_fix(v0, v1, mean, rstd, c.ln); }
        f32x4 am0, am1, a00, a01, ap0, ap1; unpack8(t.wm, am0, am1); unpack8(t.w0, a00, a01); unpack8(t.wp, ap0, ap1);
        f32x4 c0v = c.b[0] + c.w0[0] * am0 + c.w1[0] * a00 + c.w2[0] * ap0;
        f32x4 c1v = c.b[1] + c.w0[1] * am1 + c.w1[1] * a01 + c.w2[1] * ap1;
#pragma unroll
        for (int e = 0; e < 4; ++e) { c0v[e] = gelu_tanh(c0v[e]) * v0[e]; c1v[e] = gelu_tanh(c1v[e]) * v1[e]; }
        *(GAS u32x4*)(Gout + (size_t)row * DFF + c0) = pack8(c0v, c1v);
    }
};
#ifndef UPC_SCHED
#define UPC_SCHED 2
#endif
struct EpiUpConv {
    static constexpr bool PERM = true, AFTER_DRAIN = false; FUpConv f;
    template <int NB> __device__ __forceinline__ void batch(const f32x4 (&acc)[2][2][4][2], int ai, int bj, int m0, int row0, int c0, const FUpConv::Ctx& ctx) const {
        FUpConv::Tmp tmp[NB];
#pragma unroll
        for (int m = 0; m < NB; ++m) f.load(row0 + ai * 128 + (m0 + m) * 16, c0, tmp[m]);
#pragma unroll
        for (int m = 0; m < NB; ++m) f.apply(row0 + ai * 128 + (m0 + m) * 16, c0, acc[ai][bj][m0 + m][0], acc[ai][bj][m0 + m][1], ctx, tmp[m]);
        asm volatile("" ::: "memory");
    }
    __device__ __forceinline__ void operator()(const f32x4 (&acc)[2][2][4][2], const pg8::Unit& u, int wr, int wc, int fr, int fq) const {
        const int row0 = u.pm * 256 + wr * 64 + fr, col0 = u.pn * 256 + wc * 32 + 8 * fq;
        { FUpConv::Ctx ctx; f.prep(col0, ctx);
#if UPC_SCHED == 1
          batch<1>(acc, 0, 0, 0, row0, col0, ctx); batch<1>(acc, 0, 0, 1, row0, col0, ctx); batch<1>(acc, 0, 0, 2, row0, col0, ctx); batch<1>(acc, 0, 0, 3, row0, col0, ctx);
          batch<2>(acc, 1, 0, 0, row0, col0, ctx); batch<2>(acc, 1, 0, 2, row0, col0, ctx);
#elif UPC_SCHED == 2
          batch<1>(acc, 0, 0, 0, row0, col0, ctx); batch<1>(acc, 0, 0, 1, row0, col0, ctx); batch<2>(acc, 0, 0, 2, row0, col0, ctx);
          batch<2>(acc, 1, 0, 0, row0, col0, ctx); batch<2>(acc, 1, 0, 2, row0, col0, ctx);
#else
          batch<1>(acc, 0, 0, 0, row0, col0, ctx); batch<1>(acc, 0, 0, 1, row0, col0, ctx); batch<2>(acc, 0, 0, 2, row0, col0, ctx);
          batch<4>(acc, 1, 0, 0, row0, col0, ctx);
#endif
        }
        { FUpConv::Ctx ctx; f.prep(col0 + 128, ctx);
          batch<4>(acc, 0, 1, 0, row0, col0 + 128, ctx); batch<4>(acc, 1, 1, 0, row0, col0 + 128, ctx); }
    }
};
#define DPP_SHR1(keep, x) __int_as_float(__builtin_amdgcn_update_dpp(__float_as_int(keep), __float_as_int(x), 0x111, 0xf, 0xf, false))
#define DPP_SHL1(keep, x) __int_as_float(__builtin_amdgcn_update_dpp(__float_as_int(keep), __float_as_int(x), 0x101, 0xf, 0xf, false))
#define DPP_ROR1(x) __int_as_float(__builtin_amdgcn_update_dpp(0, __float_as_int(x), 0x121, 0xf, 0xf, false))
#define DPP_ROL1(x) __int_as_float(__builtin_amdgcn_update_dpp(0, __float_as_int(x), 0x12F, 0xf, 0xf, false))
struct EpiGateUp {
    static constexpr bool PERM = true, AFTER_DRAIN = false;
    bf16_t* Gout; bf16_t* BA; bf16_t* BU; float* BC; const float* cw; const float* cb; const float* st; const float* vec;
    __device__ __forceinline__ void operator()(const f32x4 (&acc)[2][2][4][2], const pg8::Unit& u, int wr, int wc, int fr, int fq) const {
        const int row0 = u.pm * 256 + wr * 64 + fr, hc = u.pn * 128 + wc * 32 + 8 * fq;
#pragma unroll
        for (int h = 0; h < 2; ++h) {
            const int c4 = hc + 4 * h;
            const f32x4 csG = *(const GAS f32x4*)(vec + V_CSG + c4), bwG = *(const GAS f32x4*)(vec + V_BWG + c4), csU = *(const GAS f32x4*)(vec + V_CSU + c4), bwU = *(const GAS f32x4*)(vec + V_BWU + c4);
            const f32x4 w0 = *(const GAS f32x4*)(cw + c4), w1 = *(const GAS f32x4*)(cw + DFF + c4), w2 = *(const GAS f32x4*)(cw + 2 * DFF + c4), bb = *(const GAS f32x4*)(cb + c4);
#pragma unroll
            for (int ai = 0; ai < 2; ++ai) {
                f32x4 af[4], uf[4];
#pragma unroll
                for (int m = 0; m < 4; ++m) {
                    StTmp s; s.s = *(const GAS f32x2v*)(st + 2 * (size_t)(row0 + ai * 128 + m * 16)); float mean, rstd; st_decode(s, mean, rstd);
                    af[m] = (acc[ai][0][m][h] - csG * mean) * rstd + bwG; uf[m] = (acc[ai][1][m][h] - csU * mean) * rstd + bwU;
                }
#pragma unroll
                for (int m = 0; m < 4; ++m) {
                    f32x4 pv, nx;
#pragma unroll
                    for (int e = 0; e < 4; ++e) {
                        const float keepP = m > 0 ? DPP_ROR1(af[m > 0 ? m - 1 : 0][e]) : 0.f; pv[e] = DPP_SHR1(keepP, af[m][e]);
                        const float keepN = m < 3 ? DPP_ROL1(af[m < 3 ? m + 1 : 3][e]) : 0.f; nx[e] = DPP_SHL1(keepN, af[m][e]);
                    }
                    f32x4 c = bb + w0 * pv + w1 * af[m] + w2 * nx;
                    const int row = row0 + ai * 128 + m * 16;
                    const bool defer = (m == 0 && fr == 0) || (m == 3 && fr == 15);
                    if (!defer) {
#pragma unroll
                        for (int e = 0; e < 4; ++e) c[e] = gelu_tanh(c[e]) * uf[m][e];
                        u32x2v w; w.x = cvt_pk(c[0], c[1]); w.y = cvt_pk(c[2], c[3]);
                        *(GAS u32x2v*)(Gout + (size_t)row * DFF + c4) = w;
                    } else {
                        const size_t bo = (size_t)(2 * (row >> 6) + (m == 3 ? 1 : 0)) * DFF + c4;
                        u32x2v wa, wu; wa.x = cvt_pk(af[m][0], af[m][1]); wa.y = cvt_pk(af[m][2], af[m][3]); wu.x = cvt_pk(uf[m][0], uf[m][1]); wu.y = cvt_pk(uf[m][2], uf[m][3]);
                        *(GAS u32x2v*)(BA + bo) = wa; *(GAS u32x2v*)(BU + bo) = wu; *(GAS f32x4*)(BC + bo) = c;
                    }
                }
            }
        }
    }
};
__device__ __forceinline__ void ffn_fixup_phase(bf16_t* __restrict__ G, const bf16_t* __restrict__ BA, const bf16_t* __restrict__ BU, const float* __restrict__ BC, const float* __restrict__ cw, int gt, int NTH) {
    for (int idx = gt; idx < (M / 32) * (DFF / 4); idx += NTH) {
        const int brow = idx / (DFF / 4), c4 = (idx % (DFF / 4)) * 4, r = 64 * (brow >> 1) + 63 * (brow & 1);
        const size_t bo = (size_t)brow * DFF + c4;
        f32x4 c = *(const GAS f32x4*)(BC + bo); const u32x2v wu = *(const GAS u32x2v*)(BU + bo);
        const bool lo = (brow & 1) == 0; const bool edge = lo ? (r & (SEQ - 1)) == 0 : (r & (SEQ - 1)) == SEQ - 1;
        if (!edge) { const u32x2v wa = *(const GAS u32x2v*)(BA + (lo ? bo - DFF : bo + DFF)); const f32x4 wt = *(const GAS f32x4*)(cw + (lo ? 0 : 2 * DFF) + c4);
            c[0] += wt[0] * bf_lo(wa.x); c[1] += wt[1] * bf_hi(wa.x); c[2] += wt[2] * bf_lo(wa.y); c[3] += wt[3] * bf_hi(wa.y); }
        u32x2v w; w.x = cvt_pk(gelu_tanh(c[0]) * bf_lo(wu.x), gelu_tanh(c[1]) * bf_hi(wu.x)); w.y = cvt_pk(gelu_tanh(c[2]) * bf_lo(wu.y), gelu_tanh(c[3]) * bf_hi(wu.y));
        *(GAS u32x2v*)(G + (size_t)r * DFF + c4) = w;
    }
}
__device__ __forceinline__ void ffn_fixup_panel(bf16_t* __restrict__ G, const bf16_t* __restrict__ BA, const bf16_t* __restrict__ BU, const float* __restrict__ BC, const float* __restrict__ cw, int pm, int tid) {
#pragma nounroll
    for (int idx = tid; idx < 8 * (DFF / 4); idx += 512) {
        const int brow = 8 * pm + idx / (DFF / 4), c4 = (idx % (DFF / 4)) * 4, r = 64 * (brow >> 1) + 63 * (brow & 1);
        const size_t bo = (size_t)brow * DFF + c4;
        f32x4 c = *(const GAS f32x4*)(BC + bo); const u32x2v wu = *(const GAS u32x2v*)(BU + bo);
        const bool lo = (brow & 1) == 0; const bool edge = lo ? (r & (SEQ - 1)) == 0 : (r & (SEQ - 1)) == SEQ - 1;
        if (!edge) { const u32x2v wa = *(const GAS u32x2v*)(BA + (lo ? bo - DFF : bo + DFF)); const f32x4 wt = *(const GAS f32x4*)(cw + (lo ? 0 : 2 * DFF) + c4);
            c[0] += wt[0] * bf_lo(wa.x); c[1] += wt[1] * bf_hi(wa.x); c[2] += wt[2] * bf_lo(wa.y); c[3] += wt[3] * bf_hi(wa.y); }
        u32x2v w; w.x = cvt_pk(gelu_tanh(c[0]) * bf_lo(wu.x), gelu_tanh(c[1]) * bf_hi(wu.x)); w.y = cvt_pk(gelu_tanh(c[2]) * bf_lo(wu.y), gelu_tanh(c[3]) * bf_hi(wu.y));
        *(GAS u32x2v*)(G + (size_t)r * DFF + c4) = w;
    }
}
struct FPle { static constexpr int NB = 2;
    struct Ctx { LnCtx ln; f32x4 g[2], b[2]; };
    struct Tmp { f32x2v s; u32x4 xb; u32x4 pj; };
    float* XF; const bf16_t* XBi; const bf16_t* PJ; bf16_t* XBo; const float* st; const float* cs; const float* bw; const float* lg; const float* lb;
    __device__ __forceinline__ void prep(int c0, Ctx& c) const {
        ln_ctx(cs, bw, c0, c.ln);
#pragma unroll
        for (int i = 0; i < 2; ++i) { c.g[i] = *(const GAS f32x4*)(lg + c0 + 4 * i); c.b[i] = *(const GAS f32x4*)(lb + c0 + 4 * i); }
    }
    __device__ __forceinline__ void load(int row, int c0, Tmp& t) const {
        const size_t o = (size_t)row * DM + c0;
        t.s = *(const GAS f32x2v*)(st + 2 * (size_t)row); t.xb = *(const GAS u32x4*)(XBi + o); t.pj = *(const GAS u32x4*)(PJ + o);
    }
    __device__ __forceinline__ void apply(int row, int c0, f32x4 v0, f32x4 v1, const Ctx& c, const Tmp& t) const {
        StTmp s{t.s}; float mean, rstd; st_decode(s, mean, rstd); ln_fix(v0, v1, mean, rstd, c.ln);
        const size_t o = (size_t)row * DM + c0;
        f32x4 x0, x1, p0, p1; unpack8(t.xb, x0, x1); unpack8(t.pj, p0, p1);
        x0 = (x0 - mean) * rstd * c.g[0] + c.b[0]; x1 = (x1 - mean) * rstd * c.g[1] + c.b[1];
#pragma unroll
        for (int e = 0; e < 4; ++e) { x0[e] += p0[e] * __builtin_amdgcn_rcpf(1.0f + fexp2(-LOG2E * v0[e])); x1[e] += p1[e] * __builtin_amdgcn_rcpf(1.0f + fexp2(-LOG2E * v1[e])); }
        if (XF) { *(GAS f32x4*)(XF + o) = x0; *(GAS f32x4*)(XF + o + 4) = x1; } if (XBo) *(GAS u32x4*)(XBo + o) = pack8(x0, x1);
    }
};
struct FCqkv { static constexpr int NB = 4;
    typedef NoCtx Ctx; typedef RopeTmp Tmp; bf16_t *Q, *K, *V; const float* ropeA;
    __device__ __forceinline__ void prep(int, Ctx&) const {}
    __device__ __forceinline__ void load(int row, int c0, Tmp& t) const { if (c0 < 2048 && (c0 & 63) < 16) rope_ld(t, ropeA + (size_t)row * 16 + (c0 & 63)); }
    __device__ __forceinline__ void apply(int row, int c0, f32x4 v0, f32x4 v1, const Ctx&, const Tmp& t) const {
        const int sec = c0 >> 10, cc = c0 & 1023;
        if (sec < 2 && (cc & 63) < 16) rope8t(v0, v1, t);
        if (sec == 0) { v0 = v0 * QS_C; v1 = v1 * QS_C; }
        bf16_t* dst = (sec == 0 ? Q : (sec == 1 ? K : V)) + (size_t)row * 1024 + cc;
        *(u32x4*)dst = pack8(v0, v1);
    }
};
template <bool LNRES> struct EpiResidStat {
    static constexpr bool PERM = true, AFTER_DRAIN = false;
    const float* res; const float* pst; const float* pg; const float* pb; bf16_t* xb; float* st; const bf16_t* resb;
    __device__ __forceinline__ void operator()(const f32x4 (&acc)[2][2][4][2], const pg8::Unit& u, int wr, int wc, int fr, int fq) const {
        const int row0 = u.pm * 256 + wr * 64 + fr, col0 = u.pn * 256 + wc * 32 + 8 * fq;
        f32x4 g[2][2], b[2][2];
        if (LNRES) {
#pragma unroll
            for (int bj = 0; bj < 2; ++bj)
#pragma unroll
                for (int i = 0; i < 2; ++i) { g[bj][i] = *(const GAS f32x4*)(pg + col0 + 128 * bj + 4 * i); b[bj][i] = *(const GAS f32x4*)(pb + col0 + 128 * bj + 4 * i); }
        }
        constexpr int NB = LNRES ? 2 : 4;
#pragma unroll
        for (int aim = 0; aim < 8; aim += NB) {
            const int ai = aim >> 2, mb = aim & 3;
            f32x4 r[LNRES ? 1 : NB][2][2]; u32x4 rb[LNRES ? NB : 1][2]; f32x2v sv[NB];
#pragma unroll
            for (int mm = 0; mm < NB; ++mm) {
                const int m = mb + mm; const int row = row0 + ai * 128 + m * 16;
                if (LNRES) sv[mm] = *(const GAS f32x2v*)(pst + 2 * (size_t)row);
#pragma unroll
                for (int bj = 0; bj < 2; ++bj) { const size_t o = (size_t)row * DM + col0 + 128 * bj;
                    if (LNRES) rb[LNRES ? mm : 0][bj] = *(const GAS u32x4*)(xb + o);
                    else if (resb) { const u32x4 w_ = *(const GAS u32x4*)(resb + o); unpack8(w_, r[LNRES ? 0 : mm][bj][0], r[LNRES ? 0 : mm][bj][1]); }
                    else { r[LNRES ? 0 : mm][bj][0] = *(const GAS f32x4*)(res + o); r[LNRES ? 0 : mm][bj][1] = *(const GAS f32x4*)(res + o + 4); } }
            }
#pragma unroll
            for (int mm = 0; mm < NB; ++mm) {
                const int m = mb + mm; const int row = row0 + ai * 128 + m * 16;
                float mean = 0.f, rstd = 1.f; if (LNRES) { StTmp s{sv[mm]}; st_decode(s, mean, rstd); }
                float s = 0.f, ss = 0.f;
#pragma unroll
                for (int bj = 0; bj < 2; ++bj) {
                    const size_t o = (size_t)row * DM + col0 + 128 * bj;
                    f32x4 r0, r1;
                    if (LNRES) { unpack8(rb[LNRES ? mm : 0][bj], r0, r1); r0 = (r0 - mean) * rstd * g[bj][0] + b[bj][0]; r1 = (r1 - mean) * rstd * g[bj][1] + b[bj][1]; }
                    else { r0 = r[LNRES ? 0 : mm][bj][0]; r1 = r[LNRES ? 0 : mm][bj][1]; }
                    const f32x4 v0 = r0 * ALPHA + acc[ai][bj][m][0], v1 = r1 * ALPHA + acc[ai][bj][m][1];
                    *(GAS u32x4*)(xb + o) = pack8(v0, v1);
                    s += (v0[0] + v0[1]) + (v0[2] + v0[3]) + (v1[0] + v1[1]) + (v1[2] + v1[3]);
                    ss += (v0[0] * v0[0] + v0[1] * v0[1]) + (v0[2] * v0[2] + v0[3] * v0[3]) + (v1[0] * v1[0] + v1[1] * v1[1]) + (v1[2] * v1[2] + v1[3] * v1[3]);
                }
                s += __shfl_xor(s, 16); s += __shfl_xor(s, 32); ss += __shfl_xor(ss, 16); ss += __shfl_xor(ss, 32);
                if (fq == 0) { __builtin_amdgcn_global_atomic_fadd_f32((GAS float*)(st + 2 * (size_t)row), s); __builtin_amdgcn_global_atomic_fadd_f32((GAS float*)(st + 2 * (size_t)row + 1), ss); }
            }
            asm volatile("" ::: "memory");
        }
    }
};
template <class E> __device__ __forceinline__ void run_gemm_e(LAS unsigned char* lds, const bf16_t* A, const bf16_t* Bt, int N, int K, int G, const E& e) {
    pg8::Gemm g{A, Bt, M, N, K}; pg8::StaticOrder S; S.init(M, N, G, (int)blockIdx.x);
    pg8::gemm_phase<E, pg8::StaticOrder, true, true>(lds, g, S, e);
}
__device__ __forceinline__ void colvec_item(const float* __restrict__ W, int ldw, int n0, const float* __restrict__ g, const float* __restrict__ b, float* cs, float* bw, LAS float* red, int wave, int lane) {
    float s0 = 0.f, s1 = 0.f;
#pragma unroll 16
    for (int k = wave * 128; k < wave * 128 + 128; ++k) { const float w = W[(size_t)k * ldw + n0 + lane]; s0 += bf_lo(cvt_pk(w * g[k], 0.f)); s1 += w * b[k]; }
    red[(wave * 64 + lane) * 2] = s0; red[(wave * 64 + lane) * 2 + 1] = s1;
    __syncthreads();
    if (wave == 0) { float t0 = 0.f, t1 = 0.f;
#pragma unroll
        for (int w = 0; w < 8; ++w) { t0 += red[(w * 64 + lane) * 2]; t1 += red[(w * 64 + lane) * 2 + 1]; }
        cs[n0 + lane] = t0; bw[n0 + lane] = t1; }
    __syncthreads();
}
template <class F> __device__ __forceinline__ void run_gemm(LAS unsigned char* lds, const bf16_t* A, const bf16_t* Bt, int N, int K, int G, const F& f) {
    pg8::Gemm g{A, Bt, M, N, K}; pg8::StaticOrder S; S.init(M, N, G, (int)blockIdx.x);
    Epi8<F> E{f};
    pg8::gemm_phase<Epi8<F>, pg8::StaticOrder, true, true>(lds, g, S, E);
}

struct MapId { __device__ __forceinline__ int operator()(int n) const { return n; } };
__device__ __forceinline__ int il16(int w) { return (w & 1) ? 8 + (w >> 1) : (w >> 1); }
__device__ __forceinline__ int il32(int w) { return (w & 1) ? 16 + (w >> 1) : (w >> 1); }
struct MapRope64 { int lim; __device__ __forceinline__ int operator()(int n) const { if (n < lim) { const int w = n & 63; if (w < 16) return (n - w) + il16(w); } return n; } };
struct MapWin { __device__ __forceinline__ int operator()(int n) const {
    if (n < 1024) { const int w = n & 63; return w < 16 ? (n - w) + il16(w) : n; }
    if (n < 2176) return n;
    if (n < 2208) return 2176 + il32(n - 2176);
    return -1; } };
struct MapQup { __device__ __forceinline__ int operator()(int n) const { const int w = n % 96; return w >= 64 ? (n - w) + 64 + il32(w - 64) : n; } };
struct MapKvup { __device__ __forceinline__ int operator()(int n) const { if (n < 512) return (n >> 6) * 128 + (n & 63); const int m = n - 512; return (m >> 6) * 128 + 64 + (m & 63); } };
template <class Map> __device__ __forceinline__ void prep_item(const float* __restrict__ W, int K, int ldw, bf16_t* __restrict__ WT, int Nout, Map map, LAS float* scr, int it, int lane,
                                                               const float* __restrict__ gain = nullptr, const float* __restrict__ bias = nullptr, float* pcs = nullptr, float* pbw = nullptr, int rowmap = 0) {
    const int nblk = Nout / 32;
    const int kb = it / nblk, nb = it % nblk, k0 = 64 * kb, n0 = 32 * nb;
    const int rb = rowmap == 0 ? n0 : 256 * (n0 >> 7) + (n0 & 127) + (rowmap == 2 ? 128 : 0);
    const int src = map(n0 + (lane & 31));
    float wv[32];
#pragma unroll
    for (int i = 0; i < 32; ++i) { const int kk = 2 * i + (lane >> 5); wv[i] = src >= 0 ? W[(size_t)(k0 + kk) * ldw + src] : 0.f; }
    if (gain) {
        float s0 = 0.f, s1 = 0.f;
#pragma unroll
        for (int i = 0; i < 32; ++i) { const int kk = 2 * i + (lane >> 5); const float w = wv[i]; s1 += w * bias[k0 + kk]; wv[i] = w * gain[k0 + kk]; s0 += bf_lo(cvt_pk(wv[i], 0.f)); }
        s0 += __shfl_xor(s0, 32); s1 += __shfl_xor(s1, 32);
        if (lane < 32) { pcs[(size_t)kb * VEC_L + n0 + lane] = s0; pbw[(size_t)kb * VEC_L + n0 + lane] = s1; }
    }
#pragma unroll
    for (int i = 0; i < 32; ++i) { const int kk = 2 * i + (lane >> 5); scr[kk * 33 + (lane & 31)] = wv[i]; }
    asm volatile("s_waitcnt lgkmcnt(0)" ::: "memory");
    const int c = lane & 7;
#pragma unroll
    for (int j = 0; j < 4; ++j) { const int n = (lane >> 3) + 8 * j; const LAS float* s = scr + (8 * c) * 33 + n;
        u32x4 o; o.x = cvt_pk(s[0 * 33], s[1 * 33]); o.y = cvt_pk(s[2 * 33], s[3 * 33]); o.z = cvt_pk(s[4 * 33], s[5 * 33]); o.w = cvt_pk(s[6 * 33], s[7 * 33]);
        *(GAS u32x4*)(WT + (size_t)(rb + n) * K + k0 + 8 * c) = o; }
    asm volatile("s_waitcnt lgkmcnt(0)" ::: "memory");
}

__device__ __forceinline__ void ln_phase(float* XF, bf16_t* XB, const float* __restrict__ g, const float* __restrict__ b, int gw, int NGW, int lane) {
    f32x4 gv[4], bv[4];
#pragma unroll
    for (int j = 0; j < 4; ++j) { gv[j] = ((const f32x4*)g)[lane + 64 * j]; bv[j] = ((const f32x4*)b)[lane + 64 * j]; }
    for (int row = gw; row < M; row += NGW) {
        f32x4* xr = (f32x4*)(XF + (size_t)row * DM) + lane;
        f32x4 v[4]; float s = 0.f;
#pragma unroll
        for (int j = 0; j < 4; ++j) { v[j] = xr[64 * j]; s += (v[j][0] + v[j][1]) + (v[j][2] + v[j][3]); }
        const float mean = wave_sum(s) * (1.f / DM); float s2 = 0.f;
#pragma unroll
        for (int j = 0; j < 4; ++j) { v[j] = v[j] - mean; s2 += (v[j][0] * v[j][0] + v[j][1] * v[j][1]) + (v[j][2] * v[j][2] + v[j][3] * v[j][3]); }
        const float rstd = 1.f / sqrtf(wave_sum(s2) * (1.f / DM) + 1e-5f);
        u32x2v* ob = (u32x2v*)(XB + (size_t)row * DM) + lane;
#pragma unroll
        for (int j = 0; j < 4; ++j) { const f32x4 y = v[j] * rstd * gv[j] + bv[j]; xr[64 * j] = y; u32x2v w; w.x = cvt_pk(y[0], y[1]); w.y = cvt_pk(y[2], y[3]); ob[64 * j] = w; }
    }
}
__device__ __forceinline__ void latnorm_phase(const float* __restrict__ LAT, bf16_t* __restrict__ CQN, bf16_t* __restrict__ CKVN, const float* __restrict__ qn, const float* __restrict__ kvn, int gw, int NGW, int lane) {
    f32x2v gq[3];
#pragma unroll
    for (int j = 0; j < 3; ++j) gq[j] = *(const GAS f32x2v*)(qn + 2 * lane + 128 * j);
    const f32x4 gk = *(const GAS f32x4*)(kvn + 4 * lane);
    for (int row = gw; row < M; row += NGW) {
        const float* lr = LAT + (size_t)row * 640;
        f32x2v q[3]; float s = 0.f;
#pragma unroll
        for (int j = 0; j < 3; ++j) { q[j] = *(const GAS f32x2v*)(lr + 2 * lane + 128 * j); s += q[j][0] * q[j][0] + q[j][1] * q[j][1]; }
        const f32x4 kv = *(const GAS f32x4*)(lr + 384 + 4 * lane);
        float s2 = (kv[0] * kv[0] + kv[1] * kv[1]) + (kv[2] * kv[2] + kv[3] * kv[3]);
        const float rq = 1.f / sqrtf(wave_sum(s) * (1.f / 384.f) + 1e-6f), rk = 1.f / sqrtf(wave_sum(s2) * (1.f / 256.f) + 1e-6f);
#pragma unroll
        for (int j = 0; j < 3; ++j) *(GAS unsigned*)(CQN + (size_t)row * 384 + 2 * lane + 128 * j) = cvt_pk(q[j][0] * rq * gq[j][0], q[j][1] * rq * gq[j][1]);
        u32x2v w; w.x = cvt_pk(kv[0] * rk * gk[0], kv[1] * rk * gk[1]); w.y = cvt_pk(kv[2] * rk * gk[2], kv[3] * rk * gk[3]);
        *(GAS u32x2v*)(CKVN + (size_t)row * 256 + 4 * lane) = w;
    }
}
__device__ __forceinline__ void merge_phase(const bf16_t* __restrict__ OA, const float* __restrict__ LSE, bf16_t* __restrict__ MIX, int gw, int NGW, int lane) {
    for (int row = gw; row < M; row += NGW) {
        const int h = lane >> 3;
        const float l0 = LSE[((size_t)0 * M + row) * 8 + h], l1 = LSE[((size_t)1 * M + row) * 8 + h], l2 = LSE[((size_t)2 * M + row) * 8 + h];
        const float mx = fmaxf(l0, fmaxf(l1, l2));
        float w0 = fexp2(l0 - mx), w1 = fexp2(l1 - mx), w2 = fexp2(l2 - mx); const float inv = 1.f / (w0 + w1 + w2); w0 *= inv; w1 *= inv; w2 *= inv;
        f32x4 a0, a1, b0, b1, c0, c1;
        unpack8(*(const GAS u32x4*)(OA + ((size_t)0 * M + row) * 512 + 8 * lane), a0, a1);
        unpack8(*(const GAS u32x4*)(OA + ((size_t)1 * M + row) * 512 + 8 * lane), b0, b1);
        unpack8(*(const GAS u32x4*)(OA + ((size_t)2 * M + row) * 512 + 8 * lane), c0, c1);
        *(GAS u32x4*)(MIX + (size_t)row * 1024 + 8 * lane) = pack8(a0 * w0 + b0 * w1 + c0 * w2, a1 * w0 + b1 * w1 + c1 * w2);
    }
}
__device__ __forceinline__ void diffcomb_phase(const bf16_t* __restrict__ O01, bf16_t* __restrict__ MIX, const float* __restrict__ lamp, const float* __restrict__ subln, int gw, int NGW, int lane) {
    const float s01 = wave_sum(lamp[lane] * lamp[64 + lane]), s23 = wave_sum(lamp[128 + lane] * lamp[192 + lane]);
    const float lam = expf(s01) - expf(s23) + LAMBDA_INIT;
    const int h = lane >> 3, d0 = (lane & 7) * 16;
    f32x4 gsub[4];
#pragma unroll
    for (int j = 0; j < 4; ++j) gsub[j] = *(const GAS f32x4*)(subln + d0 + 4 * j) * (1.0f - LAMBDA_INIT);
    for (int row = gw; row < M; row += NGW) {
        const bf16_t* p0 = O01 + (size_t)row * 2048 + (2 * h) * 128 + d0; const bf16_t* p1 = p0 + 128;
        f32x4 a[4], b[4];
        unpack8(*(const u32x4*)p0, a[0], a[1]); unpack8(*(const GAS u32x4*)(p0 + 8), a[2], a[3]);
        unpack8(*(const u32x4*)p1, b[0], b[1]); unpack8(*(const GAS u32x4*)(p1 + 8), b[2], b[3]);
        float ss = 0.f;
#pragma unroll
        for (int j = 0; j < 4; ++j) { a[j] = a[j] - b[j] * lam; ss += (a[j][0] * a[j][0] + a[j][1] * a[j][1]) + (a[j][2] * a[j][2] + a[j][3] * a[j][3]); }
        ss += __shfl_xor(ss, 1); ss += __shfl_xor(ss, 2); ss += __shfl_xor(ss, 4);
        const float r = 1.f / sqrtf(ss * (1.f / 128.f) + 1e-5f);
#pragma unroll
        for (int j = 0; j < 4; ++j) a[j] = a[j] * r * gsub[j];
        bf16_t* o = MIX + (size_t)row * 1024 + h * 128 + d0;
        *(u32x4*)o = pack8(a[0], a[1]); *(GAS u32x4*)(o + 8) = pack8(a[2], a[3]);
    }
}

__device__ __forceinline__ bf16x8 tr2(const LAS unsigned char* p0, const LAS unsigned char* p1) {
    const v4i16_t a = __builtin_amdgcn_ds_read_tr16_b64_v4i16((LAS v4i16_t*)p0), b = __builtin_amdgcn_ds_read_tr16_b64_v4i16((LAS v4i16_t*)p1);
    return (bf16x8){a[0], a[1], a[2], a[3], b[0], b[1], b[2], b[3]};
}
__device__ __forceinline__ bf16x8 packp(const f32x16& p, int b) {
    u32x4 w; w.x = cvt_pk(p[b], p[b + 1]); w.y = cvt_pk(p[b + 2], p[b + 3]); w.z = cvt_pk(p[b + 4], p[b + 5]); w.w = cvt_pk(p[b + 6], p[b + 7]);
    return __builtin_bit_cast(bf16x8, w);
}
template <int DQ, int DV, int MODE>
__device__ __forceinline__ void attn_dense_unit(LAS unsigned char* lds, const bf16_t* __restrict__ Qp, int ldq, const bf16_t* __restrict__ Kp, int ldk,
                                                const bf16_t* __restrict__ Vp, int ldv, bf16_t* Op, int ldo, int tid,
                                                const bf16_t* O0p = nullptr, int ldo0 = 0, float lam = 0.f, const float* __restrict__ gsub = nullptr) {
    constexpr int KS = DQ + 8, VS = (DV == 64) ? 96 : 160;
    constexpr int KBUF = 64 * KS * 2, VBUF = 64 * VS * 2;
    constexpr int CK = DQ / 8, CV = DV / 8, NKC = 64 * CK, NVC = 64 * CV, NKL = (NKC + 511) / 512, NVL = (NVC + 511) / 512, NT = SEQ / 64, ND = DV / 32;
    const int lane = tid & 63, wave = tid >> 6, r32 = lane & 31, hi = lane >> 5;
    int kgo[NKL], klo[NKL], vgo[NVL], vlo[NVL];
#pragma unroll
    for (int i = 0; i < NKL; ++i) { const int id = tid + 512 * i, row = id / CK, ch = id % CK; kgo[i] = row * ldk + ch * 8; klo[i] = row * KS * 2 + ch * 16; }
#pragma unroll
    for (int i = 0; i < NVL; ++i) { const int id = tid + 512 * i, row = id / CV, ch = id % CV; vgo[i] = row * ldv + ch * 8; vlo[i] = 2 * KBUF + row * VS * 2 + ch * 16; }
    u32x4 kreg[2][NKL], vreg[2][NVL];
#define ATT_LOAD(t, S) do { _Pragma("unroll") for (int i = 0; i < NKL; ++i) if (tid + 512 * i < NKC) kreg[S][i] = *(const GAS u32x4*)(Kp + (size_t)(t) * 64 * ldk + kgo[i]); \
                         _Pragma("unroll") for (int i = 0; i < NVL; ++i) if (tid + 512 * i < NVC) vreg[S][i] = *(const GAS u32x4*)(Vp + (size_t)(t) * 64 * ldv + vgo[i]); } while (0)
#define ATT_STORE(buf, vslot, S) do { _Pragma("unroll") for (int i = 0; i < NKL; ++i) if (tid + 512 * i < NKC) *(LAS u32x4*)(lds + (buf) * KBUF + klo[i]) = kreg[S][i]; \
                            _Pragma("unroll") for (int i = 0; i < NVL; ++i) if (tid + 512 * i < NVC) *(LAS u32x4*)(lds + (vslot) * VBUF + vlo[i]) = vreg[S][i]; } while (0)
    ATT_LOAD(0, 0);
    bf16x8 qf[DQ / 16];
#pragma unroll
    for (int d = 0; d < DQ / 16; ++d) qf[d] = *(const GAS bf16x8*)(Qp + (size_t)(wave * 32 + r32) * ldq + 16 * d + 8 * hi);
    ATT_STORE(0, 0, 0);
    ATT_LOAD(1, 1);
    __syncthreads();
    float mref = 0.f, lsum = 0.f; f32x16 O[ND], negm;
#pragma unroll
    for (int r = 0; r < 16; ++r) negm[r] = 0.f;
#pragma unroll
    for (int d = 0; d < ND; ++d)
#pragma unroll
        for (int r = 0; r < 16; ++r) O[d][r] = 0.f;
    const int kboff = r32 * KS * 2 + hi * 16;
    const int vboff = 2 * KBUF + ((4 * hi + ((lane & 15) >> 2)) * VS + 16 * ((lane >> 4) & 1) + 4 * (lane & 3)) * 2;
    static_assert((NT - 1) % 3 != 0, "the last tile's V slot must differ from slot 0 (the next unit's prologue writes slot 0 while waves 4-7 finish)");
    const bool grpB = __builtin_amdgcn_readfirstlane(tid >> 6) >= 4;
    int vs_prev = 2, vs_cur = 0, vs_next = 1;
    bf16x8 pf[4];
#define ATT_PV(VSLOT) do { \
        const LAS unsigned char* vb = lds + (VSLOT) * VBUF + vboff; \
        {    \
            bf16x8 vf[2 * ND + 1][2]; \
            __builtin_amdgcn_sched_barrier(0); \
        _Pragma("unroll") \
            for (int s = 0; s < 2; ++s) vf[0][s] = tr2(vb + (16 * s) * VS * 2, vb + (16 * s + 8) * VS * 2); \
        _Pragma("unroll") \
            for (int hb = 0; hb < 2 * ND; ++hb) { \
                if (hb + 1 < 2 * ND) { \
        _Pragma("unroll") \
                    for (int s = 0; s < 2; ++s) vf[hb + 1][s] = tr2(vb + (16 * (2 * ((hb + 1) & 1) + s)) * VS * 2 + ((hb + 1) >> 1) * 64, vb + (16 * (2 * ((hb + 1) & 1) + s) + 8) * VS * 2 + ((hb + 1) >> 1) * 64); \
                } \
                __builtin_amdgcn_sched_barrier(0); \
        _Pragma("unroll") \
                for (int s = 0; s < 2; ++s) O[hb >> 1] = __builtin_amdgcn_mfma_f32_32x32x16_bf16(vf[hb][s], pf[2 * (hb & 1) + s], O[hb >> 1], 0, 0, 0); \
                __builtin_amdgcn_sched_barrier(0); \
            } \
        } \
    } while (0)
#define ATT_ITER(TT, PAR) do { \
        const int cur = (PAR); \
        if ((TT) + 2 < NT) ATT_LOAD((TT) + 2, (PAR)); \
        if (grpB && (TT) > 0) ATT_PV(vs_prev); \
        const LAS unsigned char* kb = lds + cur * KBUF + kboff; \
        f32x16 p0, p1; \
        {    \
             \
            constexpr int HQ = DQ / 32; \
            bf16x8 kfa[HQ], kfb[HQ]; \
        _Pragma("unroll") \
            for (int hq = 0; hq < 2; ++hq) { \
        _Pragma("unroll") \
                for (int d = 0; d < HQ; ++d) { kfa[d] = *(const LAS bf16x8*)(kb + (hq * HQ + d) * 32); kfb[d] = *(const LAS bf16x8*)(kb + 32 * KS * 2 + (hq * HQ + d) * 32); } \
                __builtin_amdgcn_sched_barrier(0); \
        _Pragma("unroll") \
                for (int d = 0; d < HQ; ++d) { \
                    if (hq == 0 && d == 0) { p0 = __builtin_amdgcn_mfma_f32_32x32x16_bf16(kfa[d], qf[d], negm, 0, 0, 0); p1 = __builtin_amdgcn_mfma_f32_32x32x16_bf16(kfb[d], qf[d], negm, 0, 0, 0); } \
                    else { p0 = __builtin_amdgcn_mfma_f32_32x32x16_bf16(kfa[d], qf[hq * HQ + d], p0, 0, 0, 0); p1 = __builtin_amdgcn_mfma_f32_32x32x16_bf16(kfb[d], qf[hq * HQ + d], p1, 0, 0, 0); } \
                } \
                __builtin_amdgcn_sched_barrier(0); \
            } \
        } \
        float mx = fmaxf(fmaxf(p0[0], p1[0]), p0[1]); \
        _Pragma("unroll") \
        for (int r = 1; r < 16; ++r) mx = fmaxf(fmaxf(mx, p1[r]), r + 1 < 16 ? p0[r + 1] : p1[r]); \
        mx = fmaxf(mx, __shfl_xor(mx, 32)); \
        if (__any((TT) == 0 || mx > 8.0f)) {            \
            const float dl = ((TT) == 0) ? mx : fmaxf(mx, 0.f), f = fexp2(-dl); \
            mref += dl; lsum *= f; \
        _Pragma("unroll") \
            for (int r = 0; r < 16; ++r) { p0[r] -= dl; p1[r] -= dl; negm[r] = -mref; } \
        _Pragma("unroll") \
            for (int d = 0; d < ND; ++d) \
        _Pragma("unroll") \
                for (int r = 0; r < 16; ++r) O[d][r] *= f; \
        } \
        float rs = 0.f; \
        _Pragma("unroll") \
        for (int r = 0; r < 16; ++r) { p0[r] = fexp2(p0[r]); p1[r] = fexp2(p1[r]); rs += p0[r] + p1[r]; } \
        lsum += rs; \
        pf[0] = packp(p0, 0); pf[1] = packp(p0, 8); pf[2] = packp(p1, 0); pf[3] = packp(p1, 8); \
        if (!grpB) ATT_PV(vs_cur); \
        if ((TT) + 1 < NT) ATT_STORE((PAR) ^ 1, vs_next, (PAR) ^ 1); \
        __syncthreads(); \
        vs_prev = vs_cur; vs_cur = vs_next; vs_next = (vs_next == 2) ? 0 : vs_next + 1; \
    } while (0)
    for (int t = 0; t < NT; t += 2) { ATT_ITER(t, 0); ATT_ITER(t + 1, 1); }
    if (grpB) ATT_PV(vs_prev);
#undef ATT_ITER
#undef ATT_PV
#undef ATT_LOAD
#undef ATT_STORE
    const float l = lsum + __shfl_xor(lsum, 32), inv = 1.f / l;
    bf16_t* orow = Op + (size_t)(wave * 32 + r32) * ldo + 4 * hi;
    if (MODE == 0) {
#pragma unroll
        for (int d = 0; d < ND; ++d)
#pragma unroll
            for (int g = 0; g < 4; ++g) { u32x2v w; w.x = cvt_pk(O[d][4 * g] * inv, O[d][4 * g + 1] * inv); w.y = cvt_pk(O[d][4 * g + 2] * inv, O[d][4 * g + 3] * inv); *(GAS u32x2v*)(orow + 32 * d + 8 * g) = w; }
    } else {
        const bf16_t* o0row = O0p + (size_t)(wave * 32 + r32) * ldo0 + 4 * hi;
        const float li = lam * inv; float ss = 0.f;
#pragma unroll
        for (int d = 0; d < ND; ++d)
#pragma unroll
            for (int g = 0; g < 4; ++g) { const u32x2v w = *(const GAS u32x2v*)(o0row + 32 * d + 8 * g);
                const float a0 = bf_lo(w.x) - li * O[d][4 * g], a1 = bf_hi(w.x) - li * O[d][4 * g + 1], a2 = bf_lo(w.y) - li * O[d][4 * g + 2], a3 = bf_hi(w.y) - li * O[d][4 * g + 3];
                O[d][4 * g] = a0; O[d][4 * g + 1] = a1; O[d][4 * g + 2] = a2; O[d][4 * g + 3] = a3; ss += (a0 * a0 + a1 * a1) + (a2 * a2 + a3 * a3); }
        ss += __shfl_xor(ss, 32);
        const float rn = (1.0f - LAMBDA_INIT) / sqrtf(ss * (1.f / (float)DV) + 1e-5f);
#pragma unroll
        for (int d = 0; d < ND; ++d)
#pragma unroll
            for (int g = 0; g < 4; ++g) { const f32x4 gs = *(const GAS f32x4*)(gsub + 32 * d + 8 * g + 4 * hi);
                u32x2v w; w.x = cvt_pk(O[d][4 * g] * rn * gs[0], O[d][4 * g + 1] * rn * gs[1]); w.y = cvt_pk(O[d][4 * g + 2] * rn * gs[2], O[d][4 * g + 3] * rn * gs[3]); *(GAS u32x2v*)(orow + 32 * d + 8 * g) = w; }
    }
}
__device__ __forceinline__ void attn_dilated_unit(LAS unsigned char* wl, const bf16_t* __restrict__ QA, const bf16_t* __restrict__ KA, const bf16_t* __restrict__ VA,
                                                  bf16_t* __restrict__ OAp, float* __restrict__ LSEp, int b, int h, int shift, int r, int lb, int lane) {
    constexpr int VS = 96;
    const int r32 = lane & 31, hi = lane >> 5, L = SEQ >> shift, l0 = lb * 32;
    const size_t rowb = (size_t)b * SEQ;
    const int tq = ((l0 + r32) << shift) + r;
    bf16x8 qf[4];
#pragma unroll
    for (int d = 0; d < 4; ++d) qf[d] = *(const GAS bf16x8*)(QA + (rowb + tq) * 512 + h * 64 + 16 * d + 8 * hi);
    float m = NEG_BIG, lsum = 0.f; f32x16 O[2];
#pragma unroll
    for (int d = 0; d < 2; ++d)
#pragma unroll
        for (int q = 0; q < 16; ++q) O[d][q] = 0.f;
    const int vboff = ((4 * hi + ((lane & 15) >> 2)) * VS + 16 * ((lane >> 4) & 1) + 4 * (lane & 3)) * 2;
    for (int j = 0; j < 5; ++j) {
        const int kl0 = l0 - 64 + 32 * j;
        if (kl0 + 31 < 0 || kl0 >= L) continue;
        int kl = kl0 + r32; kl = kl < 0 ? 0 : (kl > L - 1 ? L - 1 : kl);
        const bf16_t* kp = KA + (rowb + (size_t)((kl << shift) + r)) * 512 + h * 64 + 8 * hi;
        bf16x8 kf[4];
#pragma unroll
        for (int d = 0; d < 4; ++d) kf[d] = *(const GAS bf16x8*)(kp + 16 * d);
        u32x4 vreg[4];
#pragma unroll
        for (int i = 0; i < 4; ++i) { const int id = lane + 64 * i, vrow = id >> 3, ch = id & 7; int kv = kl0 + vrow; kv = kv < 0 ? 0 : (kv > L - 1 ? L - 1 : kv);
            vreg[i] = *(const GAS u32x4*)(VA + (rowb + (size_t)((kv << shift) + r)) * 512 + h * 64 + ch * 8); }
        f32x16 p0;
#pragma unroll
        for (int q = 0; q < 16; ++q) p0[q] = 0.f;
#pragma unroll
        for (int d = 0; d < 4; ++d) p0 = __builtin_amdgcn_mfma_f32_32x32x16_bf16(kf[d], qf[d], p0, 0, 0, 0);
        const int ql = l0 + r32;
#pragma unroll
        for (int q = 0; q < 16; ++q) { const int klr = kl0 + (q & 3) + 8 * (q >> 2) + 4 * hi, df = klr - ql; const bool ok = klr >= 0 && klr < L && df <= 64 && df >= -64; p0[q] = ok ? p0[q] : -INFINITY; }
        float mx = p0[0];
#pragma unroll
        for (int q = 1; q < 16; ++q) mx = fmaxf(mx, p0[q]);
        mx = fmaxf(mx, __shfl_xor(mx, 32));
        const float mn = fmaxf(m, mx), al = fexp2(m - mn); m = mn;
        float rs = 0.f;
#pragma unroll
        for (int q = 0; q < 16; ++q) { p0[q] = fexp2(p0[q] - mn); rs += p0[q]; }
        lsum = lsum * al + rs;
#pragma unroll
        for (int d = 0; d < 2; ++d)
#pragma unroll
            for (int q = 0; q < 16; ++q) O[d][q] *= al;
        bf16x8 pf[2]; pf[0] = packp(p0, 0); pf[1] = packp(p0, 8);
#pragma unroll
        for (int i = 0; i < 4; ++i) { const int id = lane + 64 * i; *(LAS u32x4*)(wl + (id >> 3) * VS * 2 + (id & 7) * 16) = vreg[i]; }
        const LAS unsigned char* vb = wl + vboff;
#pragma unroll
        for (int d = 0; d < 2; ++d)
#pragma unroll
            for (int s = 0; s < 2; ++s) {
                const bf16x8 vf = tr2(vb + (16 * s) * VS * 2 + d * 64, vb + (16 * s + 8) * VS * 2 + d * 64);
                O[d] = __builtin_amdgcn_mfma_f32_32x32x16_bf16(vf, pf[s], O[d], 0, 0, 0);
            }
    }
    const float l = lsum + __shfl_xor(lsum, 32), inv = 1.f / l;
    bf16_t* orow = OAp + (rowb + tq) * 512 + h * 64 + 4 * hi;
#pragma unroll
    for (int d = 0; d < 2; ++d)
#pragma unroll
        for (int g = 0; g < 4; ++g) { u32x2v w; w.x = cvt_pk(O[d][4 * g] * inv, O[d][4 * g + 1] * inv); w.y = cvt_pk(O[d][4 * g + 2] * inv, O[d][4 * g + 3] * inv); *(GAS u32x2v*)(orow + 32 * d + 8 * g) = w; }
    if (hi == 0) LSEp[(rowb + tq) * 8 + h] = m + __log2f(l);
}

struct Args {
    const float* x; const float* p; const int* pos;
    const float *ab_w_in, *ab_q_norm, *ab_w_q_up, *ab_kv_norm, *ab_w_kv_up, *ab_w_out;
    const float *c_w_qkv, *c_lambda, *c_subln, *c_w_out;
    const float *ln_mix_g, *ln_mix_b, *ffn_w_gate, *ffn_w_up, *ffn_conv_w, *ffn_conv_b, *ffn_w_down, *ln_ffn_g, *ln_ffn_b, *ple_w_gate, *ple_w_proj;
    float* out; unsigned char* ws;
};

#ifndef PHM
#define PHM 0xFFFFFFFF
#endif
#ifndef DBL
#define DBL 0
#endif
#define PH(k) if ((PHM >> (k)) & 1) for (int rep_ = 0; rep_ < (((DBL >> (k)) & 1) ? 2 : 1); ++rep_)
#define FRESH() int tid = threadIdx.x; asm volatile("" : "+v"(tid)); const int lane = tid & 63, wave = __builtin_amdgcn_readfirstlane(tid >> 6); \
    unsigned char* ws0_ = a.ws; asm volatile("" : "+s"(ws0_)); unsigned char* ws = (unsigned char*)(__attribute__((address_space(1))) unsigned char*)ws0_; \
    float* xf0_ = a.out; asm volatile("" : "+s"(xf0_)); float* XF = (float*)(__attribute__((address_space(1))) float*)xf0_; \
    const int G = gridDim.x, bx = blockIdx.x, vcu = (G % 8 == 0) ? (bx % 8) * (G / 8) + bx / 8 : bx, gw = vcu * 8 + wave, NGW = G * 8; \
    (void)lane; (void)gw; (void)NGW; (void)XF; (void)ws
#define WSP(T, off) ((T*)(ws + (off)))
#ifndef ZERO_IN_KERNEL
#define ZERO_IN_KERNEL 1
#endif
#ifndef TPM
#define TPM 0
#endif
#define TB(k) do { if ((TPM >> (k)) & 1) tp_t0 = __builtin_amdgcn_s_memrealtime(); } while (0)
#define TE(k) do { if ((TPM >> (k)) & 1) tp_acc += __builtin_amdgcn_s_memrealtime() - tp_t0; } while (0)
__global__ void __launch_bounds__(512) fwd_megakernel(Args a) {
    extern __shared__ __attribute__((aligned(16))) unsigned char lds_raw[];
    LAS unsigned char* lds = (LAS unsigned char*)lds_raw;
    cg::grid_group grid = cg::this_grid();
    unsigned long long tp_t0 = 0, tp_acc = 0; (void)tp_t0;
    volatile LAS unsigned* bst = (volatile LAS unsigned*)(lds + 131072);
    if (threadIdx.x < 2) bst[threadIdx.x] = 0u;
#if ZERO_IN_KERNEL
    if (blockIdx.x == 0) { unsigned* bw = (unsigned*)a.ws; for (int i = threadIdx.x; i < 4096; i += 512) __hip_atomic_store(bw + i, 0u, __ATOMIC_RELAXED, __HIP_MEMORY_SCOPE_AGENT); }
    __syncthreads();
    XcdBarrier bar; bar.bar = (unsigned*)a.ws; bar.x = 0; bar.st = bst;
#else
    __syncthreads();
    XcdBarrier bar = xcd_barrier_post((unsigned*)a.ws, bst);
#endif
#define GSYNC() xcd_barrier(bar)

        TB(0);
    PH(0) {
        FRESH();
        const int gt = bx * 512 + tid, NTH = G * 512;
        LAS float* scr = (LAS float*)(lds + wave * 16384);
        TB(20);
        {
#define WITEM(cnt, ...) if (r < (cnt)) { prep_item(__VA_ARGS__); continue; } r -= (cnt);
            float* part = WSP(float, WS_PART);
            for (int it = gw; it < 13712; it += NGW) {
                int r = it;
                WITEM(1152, a.ab_w_in, 1024, 2208, WSP(bf16_t, WS_W_IN), 2304, MapWin{}, scr, r, lane)
                WITEM(1536, a.c_w_qkv, 1024, 3072, WSP(bf16_t, WS_W_CQKV), 3072, MapRope64{2048}, scr, r, lane)
                WITEM(144, a.ab_w_q_up, 384, 768, WSP(bf16_t, WS_W_QUP), 768, MapQup{}, scr, r, lane)
                WITEM(128, a.ab_w_kv_up, 256, 1024, WSP(bf16_t, WS_W_KVUP), 1024, MapKvup{}, scr, r, lane)
                WITEM(512, a.ab_w_out, 1024, 1024, WSP(bf16_t, WS_W_OUT0), 1024, MapId{}, scr, r, lane)
                WITEM(512, a.c_w_out, 1024, 1024, WSP(bf16_t, WS_W_OUT1), 1024, MapId{}, scr, r, lane)
                const int l = r >= 4864 ? 1 : 0; r -= l * 4864;
                float* pl = part + (size_t)l * 16 * VEC_L;
                WITEM(1408, a.ffn_w_gate + (size_t)l * 1024 * DFF, 1024, DFF, WSP(bf16_t, WS_W_GATE) + (size_t)l * 2 * DFF * 1024, DFF, MapId{}, scr, r, lane, a.ln_mix_g + l * DM, a.ln_mix_b + l * DM, pl + V_CSG, pl + V_BWG, 1)
                WITEM(1408, a.ffn_w_up + (size_t)l * 1024 * DFF, 1024, DFF, WSP(bf16_t, WS_W_GATE) + (size_t)l * 2 * DFF * 1024, DFF, MapId{}, scr, r, lane, a.ln_mix_g + l * DM, a.ln_mix_b + l * DM, pl + V_CSU, pl + V_BWU, 2)
                WITEM(1408, a.ffn_w_down + (size_t)l * DFF * 1024, DFF, 1024, WSP(bf16_t, WS_W_DOWN) + (size_t)l * 1024 * DFF, 1024, MapId{}, scr, r, lane)
                WITEM(512, a.ple_w_gate + (size_t)l * 1024 * 1024, 1024, 1024, WSP(bf16_t, WS_W_PG) + (size_t)l * 1024 * 1024, 1024, MapId{}, scr, r, lane, a.ln_ffn_g + l * DM, a.ln_ffn_b + l * DM, pl + V_CSP, pl + V_BWP)
                prep_item(a.ple_w_proj + (size_t)l * 256 * 1024, 256, 1024, WSP(bf16_t, WS_W_PP) + (size_t)l * 1024 * 256, 1024, MapId{}, scr, r, lane);
            }
#undef WITEM
        }
        TE(20); TB(21);
        { GAS f32x4* st4 = (GAS f32x4*)WSP(f32x4, WS_ST); for (int i = gt; i < 4 * M * 2 / 4; i += NTH) st4[i] = (f32x4){0.f, 0.f, 0.f, 0.f}; }
        TE(21); TB(22);
        float* ropeA = WSP(float, WS_ROPEA); float* ropeB = WSP(float, WS_ROPEB);
        {
            LAS float* invf = (LAS float*)(lds + 7 * 16384 + 12288);
            __syncthreads();
            if (tid < 24) invf[tid] = tid < 8 ? 1.0f / powf(500000.0f, (float)tid * 0.125f) : 1.0f / powf(500000.0f, (float)(tid - 8) * 0.0625f);
            __syncthreads();
            for (int idx = gt; idx < M * 24; idx += NTH) {
                const int row = idx / 24, j = idx % 24; const float ang = (float)a.pos[row] * invf[j];
                float sn, cs; sincosf(ang, &sn, &cs);
                float* dst = j < 8 ? ropeA + (size_t)row * 16 + 2 * j : ropeB + (size_t)row * 32 + 2 * (j - 8);
                *(GAS f32x2v*)dst = (f32x2v){cs, sn};
            }
        }
        TE(22); TB(23);
        GAS u32x4* XB4 = (GAS u32x4*)WSP(u32x4, WS_XB); GAS u32x4* PB4 = (GAS u32x4*)WSP(u32x4, WS_PB);
#define CVT_LOOP(SRC, DST, COUNT) do { int i_ = gt; \
            for (; i_ + 3 * NTH < (COUNT); i_ += 4 * NTH) { f32x4 v_[8]; _Pragma("unroll") for (int j_ = 0; j_ < 4; ++j_) { v_[2 * j_] = ((const f32x4*)(SRC))[2 * (i_ + j_ * NTH)]; v_[2 * j_ + 1] = ((const f32x4*)(SRC))[2 * (i_ + j_ * NTH) + 1]; } \
                _Pragma("unroll") for (int j_ = 0; j_ < 4; ++j_) (DST)[i_ + j_ * NTH] = pack8(v_[2 * j_], v_[2 * j_ + 1]); } \
            for (; i_ < (COUNT); i_ += NTH) { const f32x4 v0_ = ((const f32x4*)(SRC))[2 * i_], v1_ = ((const f32x4*)(SRC))[2 * i_ + 1]; (DST)[i_] = pack8(v0_, v1_); } } while (0)
        CVT_LOOP(a.x, XB4, M * DM / 8);
        CVT_LOOP(a.p, PB4, 2 * M * 256 / 8);
#undef CVT_LOOP
        TE(23);
    }
#if ZERO_IN_KERNEL
    grid.sync();
    bar = xcd_barrier_post((unsigned*)a.ws, bst);
#else
    if (a.ws == nullptr) grid.sync(); else GSYNC();
#endif
        TE(0);

    for (int layer = 0; layer < 2; ++layer) {
        if (layer == 0) {
        TB(1);
            PH(1) { FRESH();
                    {
                        const float* part = WSP(float, WS_PART); float* vec = WSP(float, WS_VEC);
                        for (int idx = bx * 512 + tid; idx < 2 * VEC_L; idx += G * 512) { const int l = idx / VEC_L, v = idx % VEC_L; float s = 0.f;
#pragma unroll
                            for (int kb = 0; kb < 16; ++kb) s += part[((size_t)l * 16 + kb) * VEC_L + v];
                            vec[idx] = s; }
                    }
                    run_gemm(lds, WSP(bf16_t, WS_XB), WSP(bf16_t, WS_W_IN), 2304, 1024, G,
                        FWin{WSP(bf16_t, WS_QA), WSP(bf16_t, WS_KA), WSP(bf16_t, WS_VA), WSP(float, WS_LAT), WSP(bf16_t, WS_KB), WSP(float, WS_ROPEA), WSP(float, WS_ROPEB)}); }
            GSYNC();
        TE(1);
        TB(2);
            PH(2) { FRESH(); unsigned char* dos = (unsigned char*)XF; latnorm_phase(WSP(float, WS_LAT), (bf16_t*)(dos + DO_CQN), (bf16_t*)(dos + DO_CKVN), a.ab_q_norm, a.ab_kv_norm, gw, NGW, lane); }
            GSYNC();
        TE(2);
        TB(3);
            PH(3) { FRESH(); unsigned char* dos = (unsigned char*)XF; run_gemm(lds, (bf16_t*)(dos + DO_CQN), WSP(bf16_t, WS_W_QUP), 768, 384, G, FQup{(bf16_t*)(dos + DO_QB), WSP(float, WS_ROPEB)}); }
            PH(4) { FRESH(); unsigned char* dos = (unsigned char*)XF; run_gemm(lds, (bf16_t*)(dos + DO_CKVN), WSP(bf16_t, WS_W_KVUP), 1024, 256, G, FKvup{WSP(bf16_t, WS_KB), (bf16_t*)(dos + DO_VB)}); }
            GSYNC();
        TE(3);
        TB(5);
            PH(5) {
                FRESH(); unsigned char* dos = (unsigned char*)XF;
                const bf16_t* QB = (const bf16_t*)(dos + DO_QB); const bf16_t* VB = (const bf16_t*)(dos + DO_VB); const bf16_t* KB = WSP(bf16_t, WS_KB); bf16_t* MIX = WSP(bf16_t, WS_MIX);
                constexpr int NU = BATCH * 8 * 8; const int upc = (NU + G - 1) / G;
                for (int u = vcu * upc; u < NU && u < (vcu + 1) * upc; ++u) {
                    const int ui = u - vcu * upc; const int bh = (upc == 4 && G % 8 == 0) ? (vcu >> 3) * 4 + ui : u >> 3, qb = (upc == 4 && G % 8 == 0) ? (vcu & 7) : u & 7, b = bh >> 3, h = bh & 7;
                    attn_dense_unit<96, 64, 0>(lds, QB + ((size_t)b * SEQ + qb * 256) * 768 + h * 96, 768, KB + (size_t)b * SEQ * 768 + h * 96, 768,
                                            VB + (size_t)b * SEQ * 512 + h * 64, 512, MIX + ((size_t)b * SEQ + qb * 256) * 1024 + 512 + h * 64, 1024, tid);
                }
            }
            PH(6) {
                FRESH();
                constexpr int NDU = BATCH * 8 * 3 * 64;
                LAS unsigned char* wl = lds + wave * 8192;
                for (int u = gw; u < NDU; u += NGW) {
                    const int lbr = u & 63, rest = u >> 6, pt = rest % 3, bh = rest / 3, b = bh >> 3, h = bh & 7, shift = 2 * pt;
                    const int r = lbr >> (6 - shift), lb = lbr & ((64 >> shift) - 1);
                    attn_dilated_unit(wl, WSP(bf16_t, WS_QA), WSP(bf16_t, WS_KA), WSP(bf16_t, WS_VA), WSP(bf16_t, WS_OA) + (size_t)pt * M * 512, WSP(float, WS_LSE) + (size_t)pt * M * 8, b, h, shift, r, lb, lane);
                }
            }
            GSYNC();
        TE(5);
        TB(7);
            PH(7) { FRESH(); merge_phase(WSP(bf16_t, WS_OA), WSP(float, WS_LSE), WSP(bf16_t, WS_MIX), gw, NGW, lane); }
            GSYNC();
        TE(7);
        TB(8);
            PH(8) { FRESH(); run_gemm_e(lds, WSP(bf16_t, WS_MIX), WSP(bf16_t, WS_W_OUT0), 1024, 1024, G, EpiResidStat<false>{a.x, nullptr, nullptr, nullptr, WSP(bf16_t, WS_XB), WSP(float, WS_ST)}); }
            GSYNC();
        TE(8);
        } else {
        TB(9);
            PH(9) { FRESH(); run_gemm(lds, (const bf16_t*)XF, WSP(bf16_t, WS_W_CQKV), 3072, 1024, G, FCqkv{WSP(bf16_t, WS_QC), WSP(bf16_t, WS_KC), WSP(bf16_t, WS_VC), WSP(float, WS_ROPEA)}); }
            GSYNC();
        TE(9);
        TB(10);
            PH(10) {
                FRESH();
                const bf16_t* QC = WSP(bf16_t, WS_QC); const bf16_t* KC = WSP(bf16_t, WS_KC); const bf16_t* VC = WSP(bf16_t, WS_VC); bf16_t* O0 = WSP(bf16_t, WS_O0); bf16_t* MIX1 = WSP(bf16_t, WS_MIX1);
                const float s01 = wave_sum(a.c_lambda[lane] * a.c_lambda[64 + lane]), s23 = wave_sum(a.c_lambda[128 + lane] * a.c_lambda[192 + lane]);
                const float lam = expf(s01) - expf(s23) + LAMBDA_INIT;
                constexpr int NU = BATCH * 8 * 8 * 2; int upc = (NU + G - 1) / G; upc += upc & 1;
                for (int u = vcu * upc; u < NU && u < (vcu + 1) * upc; ++u) {
                    const int ui = u - vcu * upc; const bool grp = (upc == 8 && G % 8 == 0);
                    const int c = u & 1, qb = grp ? (vcu & 7) : (u >> 1) & 7, bh = grp ? (vcu >> 3) * 4 + (ui >> 1) : u >> 4, b = bh >> 3, h = bh & 7, hh = 2 * h + c;
                    const size_t qrow = (size_t)b * SEQ + qb * 256;
                    if (c == 0) attn_dense_unit<64, 128, 0>(lds, QC + qrow * 1024 + hh * 64, 1024, KC + (size_t)b * SEQ * 1024 + hh * 64, 1024, VC + (size_t)b * SEQ * 1024 + h * 128, 1024,
                                                            O0 + qrow * 1024 + h * 128, 1024, tid);
                    else attn_dense_unit<64, 128, 1>(lds, QC + qrow * 1024 + hh * 64, 1024, KC + (size_t)b * SEQ * 1024 + hh * 64, 1024, VC + (size_t)b * SEQ * 1024 + h * 128, 1024,
                                                     MIX1 + qrow * 1024 + h * 128, 1024, tid, O0 + qrow * 1024 + h * 128, 1024, lam, a.c_subln);
                }
            }
            GSYNC();
        TE(10);
        TB(12);
            PH(12) { FRESH(); run_gemm_e(lds, WSP(bf16_t, WS_MIX1), WSP(bf16_t, WS_W_OUT1), 1024, 1024, G, EpiResidStat<false>{nullptr, nullptr, nullptr, nullptr, WSP(bf16_t, WS_XB), WSP(float, WS_ST) + (size_t)2 * M * 2, (const bf16_t*)XF}); }
            GSYNC();
        TE(12);
        }
        TB(14);
        PH(14) { FRESH(); run_gemm_e(lds, WSP(bf16_t, WS_XB), WSP(bf16_t, WS_W_GATE) + (size_t)layer * 2 * DFF * 1024, 2 * DFF, 1024, G,
                     EpiGateUp{WSP(bf16_t, WS_FG), WSP(bf16_t, WS_BA), WSP(bf16_t, WS_BU), WSP(float, WS_BC), a.ffn_conv_w + (size_t)layer * 3 * DFF, a.ffn_conv_b + (size_t)layer * DFF,
                               WSP(float, WS_ST) + (size_t)(2 * layer) * M * 2, WSP(float, WS_VEC) + layer * VEC_L}); }
        GSYNC();
        TE(14);
        TB(16);
        PH(15) { FRESH();
#pragma nounroll
                 for (int L = bx; L < 512; L += G) {
                     const int wgid = (L & 7) * 64 + (L >> 3), pm = (wgid >> 5) * 8 + (wgid & 7);
                     ffn_fixup_panel(WSP(bf16_t, WS_FG), WSP(bf16_t, WS_BA), WSP(bf16_t, WS_BU), WSP(float, WS_BC), a.ffn_conv_w + (size_t)layer * 3 * DFF, pm, tid); }
                 asm volatile("s_waitcnt vmcnt(0)" ::: "memory"); __syncthreads(); }
        PH(16) { FRESH();
                 run_gemm_e(lds, WSP(bf16_t, WS_FG), WSP(bf16_t, WS_W_DOWN) + (size_t)layer * 1024 * DFF, 1024, DFF, G,
                     EpiResidStat<true>{nullptr, WSP(float, WS_ST) + (size_t)(2 * layer) * M * 2, a.ln_mix_g + layer * DM, a.ln_mix_b + layer * DM, WSP(bf16_t, WS_XB), WSP(float, WS_ST) + (size_t)(2 * layer + 1) * M * 2}); }
        PH(17) { FRESH(); run_gemm(lds, WSP(bf16_t, WS_PB) + (size_t)layer * M * 256, WSP(bf16_t, WS_W_PP) + (size_t)layer * 1024 * 256, 1024, 256, G, FBf16{WSP(bf16_t, WS_PJ), 1024}); }
        GSYNC();
        TE(16);
        TB(19);
        PH(19) { FRESH(); run_gemm(lds, WSP(bf16_t, WS_XB), WSP(bf16_t, WS_W_PG) + (size_t)layer * 1024 * 1024, 1024, 1024, G, FPle{layer == 0 ? (float*)nullptr : XF, WSP(bf16_t, WS_XB), WSP(bf16_t, WS_PJ), layer == 0 ? (bf16_t*)XF : (bf16_t*)nullptr,     WSP(float, WS_ST) + (size_t)(2 * layer + 1) * M * 2,
                         WSP(float, WS_VEC) + layer * VEC_L + V_CSP, WSP(float, WS_VEC) + layer * VEC_L + V_BWP, a.ln_ffn_g + layer * DM, a.ln_ffn_b + layer * DM}); }
        GSYNC();
        TE(19);
    }
    if (TPM) { const unsigned long long t1 = __builtin_amdgcn_s_memrealtime(); while (__builtin_amdgcn_s_memrealtime() - t1 < tp_acc) __builtin_amdgcn_s_sleep(8); }
}

extern "C" void kernel_launch(void* const* d_in, const int* in_sizes, int n_in, void* d_out, int out_size, void* d_ws, size_t ws_size, hipStream_t stream) {
    static int grid = 0;
    if (grid == 0) {
        if (n_in != 24 || out_size != M * DM || ws_size < WS_NEED) { fprintf(stderr, "kernel_launch: unexpected shapes (n_in %d out %d ws %zu)\n", n_in, out_size, ws_size); grid = -1; return; }
        int dev = 0, cus = 0, per_cu = 0;
        hipGetDevice(&dev); hipDeviceGetAttribute(&cus, hipDeviceAttributeMultiprocessorCount, dev);
        hipFuncSetAttribute((const void*)fwd_megakernel, hipFuncAttributeMaxDynamicSharedMemorySize, LDS_BYTES);
        hipOccupancyMaxActiveBlocksPerMultiprocessor(&per_cu, (const void*)fwd_megakernel, 512, LDS_BYTES);
        if (per_cu < 1) { fprintf(stderr, "kernel_launch: occupancy query says %d blocks per CU\n", per_cu); per_cu = 1; }
        grid = cus;
        (void)hipGetLastError();
    }
    if (grid < 0) return;
    if (!ZERO_IN_KERNEL && hipMemsetAsync(d_ws, 0, 16384, stream) != hipSuccess) { fprintf(stderr, "kernel_launch: memset of the barrier words failed\n"); return; }
    Args a{};
    a.x = (const float*)d_in[0]; a.p = (const float*)d_in[1]; a.pos = (const int*)d_in[2];
    a.ab_w_in = (const float*)d_in[3]; a.ab_q_norm = (const float*)d_in[4]; a.ab_w_q_up = (const float*)d_in[5]; a.ab_kv_norm = (const float*)d_in[6];
    a.ab_w_kv_up = (const float*)d_in[7]; a.ab_w_out = (const float*)d_in[8]; a.c_w_qkv = (const float*)d_in[9]; a.c_lambda = (const float*)d_in[10];
    a.c_subln = (const float*)d_in[11]; a.c_w_out = (const float*)d_in[12]; a.ln_mix_g = (const float*)d_in[13]; a.ln_mix_b = (const float*)d_in[14];
    a.ffn_w_gate = (const float*)d_in[15]; a.ffn_w_up = (const float*)d_in[16]; a.ffn_conv_w = (const float*)d_in[17]; a.ffn_conv_b = (const float*)d_in[18];
    a.ffn_w_down = (const float*)d_in[19]; a.ln_ffn_g = (const float*)d_in[20]; a.ln_ffn_b = (const float*)d_in[21]; a.ple_w_gate = (const float*)d_in[22]; a.ple_w_proj = (const float*)d_in[23];
    a.out = (float*)d_out; a.ws = (unsigned char*)d_ws;
    void* args[] = {&a};
    hipError_t e = hipLaunchCooperativeKernel((const void*)fwd_megakernel, dim3(grid), dim3(512), args, LDS_BYTES, stream);
    if (e != hipSuccess) fprintf(stderr, "kernel_launch: cooperative launch failed: %s (grid %d)\n", hipGetErrorString(e), grid);
}
```

```cpp
#include <hip/hip_runtime.h>
#include <hip/hip_cooperative_groups.h>
#include <cstdio>
#include <cstdint>
namespace cg = cooperative_groups;
namespace pg8 {
#define PG8_LAS __attribute__((address_space(3)))
typedef unsigned short bf16_t;
typedef short bf16x8 __attribute__((ext_vector_type(8)));
typedef float f32x4 __attribute__((ext_vector_type(4)));
typedef unsigned u32x4 __attribute__((ext_vector_type(4)));
constexpr int BM = 256, BK = 64, HALF = 128, HTB = HALF * BK * 2  , STAGE_BYTES = 8 * HTB, NXCD = 8, WGM = 8;

__host__ __device__ __forceinline__ int lds_byte(int r, int c) { const int st = (r >> 4) * 2 + (c >> 5), rr = r & 15, cc = c & 31, ob = rr * 64 + cc * 2; return st * 1024 + (ob ^ (((ob >> 9) & 1) << 5)); }
__host__ __device__ __forceinline__ void stage_rc(int b, int& R, int& C) { const int st = b / 1024, sb = b % 1024, swz = sb ^ (((sb >> 9) & 1) << 5); R = (st >> 1) * 16 + swz / 64; C = (st & 1) * 32 + (swz % 64) / 2; }
__host__ __device__ __forceinline__ int perm32(int rho) { const int n = rho >> 4, i = rho & 15; return 8 * (i >> 2) + 4 * n + (i & 3); }

struct Unit { int pm, pn; };
struct Gemm { const bf16_t* A; const bf16_t* Bt; int M, N, K; };

struct StaticOrder {
    int nM, nN, nwg, G, c;
    __host__ __device__ void init(int M, int N, int G_, int c_) { nM = M / BM; nN = N / BM; nwg = nM * nN; G = G_; c = c_; }
    __host__ __device__ bool next(int i, Unit& u) const {
        const long L = (long)i * G + c; if (L >= nwg) return false;
        int wgid = (int)L; { const int q = nwg / NXCD, r = nwg % NXCD, xcd = wgid % NXCD, off = wgid / NXCD; wgid = (xcd < r ? xcd * (q + 1) : r * (q + 1) + (xcd - r) * q) + off; }
        const int nig = WGM * nN, gid = wgid / nig, fm = gid * WGM, gsz = (nM - fm) < WGM ? (nM - fm) : WGM;
        u.pm = fm + ((wgid % nig) % gsz); u.pn = (wgid % nig) / gsz; return true;
    }
    __device__ __forceinline__ void a_ready(const Unit&) const {}
    __device__ __forceinline__ void done(const Unit&) const {}
};

__device__ __forceinline__ unsigned cvt_pk_bf16(float lo, float hi) { unsigned r; asm volatile("v_cvt_pk_bf16_f32 %0, %1, %2" : "=v"(r) : "v"(lo), "v"(hi)); return r; }
template <class Epi, class Sched, bool ALIGN_EPI = false, bool SP2 = false>
__device__ __forceinline__ void gemm_phase(PG8_LAS unsigned char* lds, const Gemm g, const Sched& S, const Epi& E) {
    int tid = threadIdx.x; asm volatile("" : "+v"(tid));
    const int wid = __builtin_amdgcn_readfirstlane(tid >> 6), lane = tid & 63, wr = wid >> 2, wc = wid & 3, fr = lane & 15, fq = lane >> 4;
    const int K = g.K, nt = K / BK;
    unsigned voffA[2], voffB[2];
#pragma unroll
    for (int i = 0; i < 2; ++i) { int R, C; stage_rc(tid * 16 + i * 8192, R, C); const int Rb = Epi::PERM ? ((R & ~31) + perm32(R & 31)) : R;
        voffA[i] = (unsigned)(R * K + C) * 2u; voffB[i] = (unsigned)(Rb * K + C) * 2u; }
    const size_t kstep = (size_t)(BK * 2);
    const size_t hstep = (size_t)HALF * K * 2;
    const size_t tstep = 2 * hstep;
    const unsigned ldsw = (unsigned)wid * 1024u;
    const int aoff = lds_byte(wr * 64 + fr, fq * 8), boff = lds_byte(wc * 32 + fr, fq * 8);
#define PG8_SA(b, h) (((b) * 2 + (h)) * HTB)
#define PG8_SB(b, h) ((4 + (b) * 2 + (h)) * HTB)
#define PG8_STAGE(bufoff, gbase, voff) do { _Pragma("unroll") for (int _i = 0; _i < 2; ++_i) \
        __builtin_amdgcn_global_load_lds((const unsigned*)((const char*)(gbase) + (voff)[_i]), (PG8_LAS unsigned*)(lds + (bufoff) + ldsw + _i * 8192), 16, 0, 0); } while (0)
#define PG8_LDA(dst, b, h) do { _Pragma("unroll") for (int m = 0; m < 4; ++m) _Pragma("unroll") for (int k = 0; k < 2; ++k) dst[m][k] = *(const PG8_LAS bf16x8*)(lds + PG8_SA(b, h) + aoff + m * 2048 + k * 1024); } while (0)
#define PG8_LDB(dst, b, h) do { _Pragma("unroll") for (int n = 0; n < 2; ++n) _Pragma("unroll") for (int k = 0; k < 2; ++k) dst[n][k] = *(const PG8_LAS bf16x8*)(lds + PG8_SB(b, h) + boff + n * 2048 + k * 1024); } while (0)
#define PG8_MMA(ai, bj, At, Bt) do { __builtin_amdgcn_s_setprio(1); _Pragma("unroll") for (int m = 0; m < 4; ++m) _Pragma("unroll") for (int n = 0; n < 2; ++n) _Pragma("unroll") for (int k = 0; k < 2; ++k) \
        acc[ai][bj][m][n] = __builtin_amdgcn_mfma_f32_16x16x32_bf16(Bt[n][k], At[m][k], acc[ai][bj][m][n], 0, 0, 0); __builtin_amdgcn_s_setprio(0); } while (0)
#define PG8_WAIT_V(n) asm volatile("s_waitcnt vmcnt(" #n ")" ::: "memory")
#define PG8_WAIT_L(n) asm volatile("s_waitcnt lgkmcnt(" #n ")" ::: "memory")
#define PG8_BAR __builtin_amdgcn_s_barrier()
#define PG8_SCHED __builtin_amdgcn_sched_barrier(0)
    Unit cur, nxt; int ui = 0;
    if (!S.next(0, cur)) return;
    f32x4 acc[2][2][4][2];
#pragma unroll
    for (int a = 0; a < 2; ++a)
#pragma unroll
        for (int b = 0; b < 2; ++b)
#pragma unroll
            for (int m = 0; m < 4; ++m)
#pragma unroll
                for (int n = 0; n < 2; ++n) acc[a][b][m][n] = (f32x4){0.f, 0.f, 0.f, 0.f};
    bf16x8 At[4][2], B0[2][2], B1[2][2];
    const char* cA = (const char*)g.A + (size_t)cur.pm * tstep; const char* cB = (const char*)g.Bt + (size_t)cur.pn * tstep;
    S.a_ready(cur);
    if constexpr (SP2) {
        PG8_STAGE(PG8_SB(0, 0), cB, voffB); PG8_STAGE(PG8_SB(0, 1), cB + hstep, voffB); PG8_STAGE(PG8_SA(0, 0), cA, voffA); PG8_STAGE(PG8_SA(0, 1), cA + hstep, voffA);
        if (wr == 1) PG8_BAR;
        PG8_WAIT_V(2); PG8_BAR;
        PG8_STAGE(PG8_SB(1, 0), cB + kstep, voffB); PG8_STAGE(PG8_SA(1, 0), cA + kstep, voffA); PG8_STAGE(PG8_SB(1, 1), cB + hstep + kstep, voffB);
        PG8_WAIT_V(6); PG8_BAR;
    } else {
        PG8_STAGE(PG8_SB(0, 0), cB, voffB); PG8_STAGE(PG8_SA(0, 0), cA, voffA); PG8_STAGE(PG8_SB(0, 1), cB + hstep, voffB); PG8_STAGE(PG8_SA(0, 1), cA + hstep, voffA);
        if (wr == 1) PG8_BAR;
        PG8_WAIT_V(4); PG8_BAR;
        PG8_STAGE(PG8_SB(1, 0), cB + kstep, voffB); PG8_STAGE(PG8_SA(1, 0), cA + kstep, voffA); PG8_STAGE(PG8_SB(1, 1), cB + hstep + kstep, voffB);
        PG8_WAIT_V(6); PG8_BAR;
    }
    for (;;) {
        const bool has_next = S.next(ui + 1, nxt);
        const char* nA = has_next ? (const char*)g.A + (size_t)nxt.pm * tstep : cA; const char* nB = has_next ? (const char*)g.Bt + (size_t)nxt.pn * tstep : cB;
#pragma nounroll
        for (int t = 0; t < nt; t += 2) {
            const bool last = (t == nt - 2);
            const char* a1 = cA + (size_t)(t + 1) * kstep;
            const char* a2 = last ? nA : cA + (size_t)(t + 2) * kstep; const char* b2 = last ? nB : cB + (size_t)(t + 2) * kstep;
            const char* a3 = a2 + kstep; const char* b3 = b2 + kstep;
            if (last && has_next) S.a_ready(nxt);
            if constexpr (SP2) {
            PG8_LDB(B0, 0, 0); PG8_LDB(B1, 0, 1); PG8_SCHED; PG8_LDA(At, 0, 0); PG8_STAGE(PG8_SA(1, 1), a1 + hstep, voffA);
            PG8_WAIT_V(8); PG8_WAIT_L(0); PG8_BAR; PG8_MMA(0, 0, At, B0); PG8_MMA(0, 1, At, B1); PG8_BAR; PG8_SCHED;
            PG8_LDA(At, 0, 1); PG8_STAGE(PG8_SB(0, 0), b2, voffB); PG8_STAGE(PG8_SB(0, 1), b2 + hstep, voffB); PG8_STAGE(PG8_SA(0, 0), a2, voffA);
            PG8_WAIT_V(8); PG8_WAIT_L(0); PG8_BAR; PG8_MMA(1, 0, At, B0); PG8_MMA(1, 1, At, B1); PG8_BAR; PG8_SCHED;
            PG8_LDB(B0, 1, 0); PG8_LDB(B1, 1, 1); PG8_SCHED; PG8_LDA(At, 1, 0); PG8_STAGE(PG8_SA(0, 1), a2 + hstep, voffA);
            PG8_WAIT_V(8); PG8_WAIT_L(0); PG8_BAR; PG8_MMA(0, 0, At, B0); PG8_MMA(0, 1, At, B1); PG8_BAR; PG8_SCHED;
            PG8_LDA(At, 1, 1); PG8_STAGE(PG8_SB(1, 0), b3, voffB); PG8_STAGE(PG8_SB(1, 1), b3 + hstep, voffB); PG8_STAGE(PG8_SA(1, 0), a3, voffA);
            PG8_WAIT_V(8); PG8_WAIT_L(0); PG8_BAR; PG8_MMA(1, 0, At, B0); PG8_MMA(1, 1, At, B1); PG8_BAR; PG8_SCHED;
            } else {
            PG8_LDB(B0, 0, 0); PG8_SCHED; PG8_LDA(At, 0, 0); PG8_STAGE(PG8_SA(1, 1), a1 + hstep, voffA);
            PG8_WAIT_L(8); PG8_BAR; PG8_WAIT_L(0); PG8_MMA(0, 0, At, B0); PG8_BAR; PG8_SCHED;
            PG8_LDB(B1, 0, 1); PG8_STAGE(PG8_SB(0, 0), b2, voffB);
            PG8_BAR; PG8_WAIT_L(0); PG8_MMA(0, 1, At, B1); PG8_BAR;
            PG8_LDA(At, 0, 1); PG8_STAGE(PG8_SA(0, 0), a2, voffA);
            PG8_BAR; PG8_WAIT_L(0); PG8_MMA(1, 0, At, B0); PG8_BAR; PG8_SCHED;
            PG8_STAGE(PG8_SB(0, 1), b2 + hstep, voffB);
            PG8_WAIT_V(6); PG8_BAR; PG8_MMA(1, 1, At, B1); PG8_BAR;
            PG8_LDB(B0, 1, 0); PG8_SCHED; PG8_LDA(At, 1, 0); PG8_STAGE(PG8_SA(0, 1), a2 + hstep, voffA);
            PG8_WAIT_L(8); PG8_BAR; PG8_WAIT_L(0); PG8_MMA(0, 0, At, B0); PG8_BAR; PG8_SCHED;
            PG8_LDB(B1, 1, 1); PG8_STAGE(PG8_SB(1, 0), b3, voffB);
            PG8_BAR; PG8_WAIT_L(0); PG8_MMA(0, 1, At, B1); PG8_BAR;
            PG8_LDA(At, 1, 1); PG8_STAGE(PG8_SA(1, 0), a3, voffA);
            PG8_BAR; PG8_WAIT_L(0); PG8_MMA(1, 0, At, B0); PG8_BAR; PG8_SCHED;
            PG8_STAGE(PG8_SB(1, 1), b3 + hstep, voffB);
            PG8_WAIT_V(6); PG8_BAR; PG8_MMA(1, 1, At, B1); PG8_BAR;
            }
        }
        if constexpr (ALIGN_EPI) { if (wr == 0) PG8_BAR; }
        if constexpr (!Epi::AFTER_DRAIN) { E(acc, cur, wr, wc, fr, fq); S.done(cur); }
        if (!has_next) break;
#pragma unroll
        for (int a = 0; a < 2; ++a)
#pragma unroll
            for (int b = 0; b < 2; ++b)
#pragma unroll
                for (int m = 0; m < 4; ++m)
#pragma unroll
                    for (int n = 0; n < 2; ++n) acc[a][b][m][n] = (f32x4){0.f, 0.f, 0.f, 0.f};
        cur = nxt; cA = nA; cB = nB; ++ui;
        if constexpr (ALIGN_EPI) { if (wr == 1) PG8_BAR; }
    }
    PG8_WAIT_V(0);
    if constexpr (!ALIGN_EPI) { if (wr == 0) PG8_BAR; }
    PG8_BAR;
    if constexpr (Epi::AFTER_DRAIN) { E.fused(acc, cur, wr, wc, fr, fq, lds, wid, lane); S.done(cur); }
#undef PG8_SA
#undef PG8_SB
#undef PG8_STAGE
#undef PG8_LDA
#undef PG8_LDB
#undef PG8_MMA
#undef PG8_WAIT_V
#undef PG8_WAIT_L
#undef PG8_BAR
#undef PG8_SCHED
}
}

#define LAS __attribute__((address_space(3)))
#define GAS __attribute__((address_space(1)))
using pg8::bf16_t; using pg8::bf16x8; using pg8::f32x4; using pg8::u32x4;
typedef float f32x16 __attribute__((ext_vector_type(16)));
typedef float f32x2v __attribute__((ext_vector_type(2)));
typedef unsigned u32x2v __attribute__((ext_vector_type(2)));
typedef short v4i16_t __attribute__((ext_vector_type(4)));
constexpr int BATCH = 16, SEQ = 2048, DM = 1024, M = BATCH * SEQ, DFF = 2816;
constexpr float ALPHA = 1.41421356237309515f, LOG2E = 1.4426950408889634f;
constexpr float QS_A = 0.125f * LOG2E, QS_B = 0.10206207261596577f * LOG2E, QS_C = 0.125f * LOG2E;
constexpr float LAMBDA_INIT = 0.8f - 0.6f * 0.74081822068171788f;
constexpr float NEG_BIG = -1e30f;
constexpr size_t MiB = (size_t)1 << 20;
constexpr size_t WS_W_IN = 1 * MiB;
constexpr size_t WS_W_QUP = WS_W_IN + (size_t)2304 * 1024 * 2;
constexpr size_t WS_W_KVUP = WS_W_QUP + (size_t)768 * 384 * 2;
constexpr size_t WS_W_OUT0 = WS_W_KVUP + (size_t)1024 * 256 * 2;
constexpr size_t WS_W_OUT1 = WS_W_OUT0 + 2 * MiB;
constexpr size_t WS_W_CQKV = WS_W_OUT1 + 2 * MiB;
constexpr size_t WS_W_GATE = WS_W_CQKV + 6 * MiB;
constexpr size_t WSZ_FF = (size_t)2816 * 1024 * 2;
constexpr size_t WS_W_UP = WS_W_GATE + 2 * WSZ_FF;
constexpr size_t WS_W_DOWN = WS_W_UP + 2 * WSZ_FF;
constexpr size_t WS_W_PG = WS_W_DOWN + 2 * WSZ_FF;
constexpr size_t WS_W_PP = WS_W_PG + 4 * MiB;
constexpr size_t WS_W_END = WS_W_PP + 2 * (size_t)1024 * 256 * 2;
static_assert(WS_W_END <= 58 * MiB, "weights region");
constexpr size_t WS_VEC = 56 * MiB;
constexpr int VEC_L = 13312, V_CSG = 0, V_BWG = 2816, V_CSU = 5632, V_BWU = 8448, V_CSP = 11264, V_BWP = 12288;
constexpr size_t WS_PART = 160 * MiB;
constexpr size_t WS_ST = 57 * MiB;
static_assert(WS_W_END <= WS_VEC, "weights vs vectors");
constexpr size_t WS_ROPEA = 58 * MiB, WS_ROPEB = 60 * MiB;
constexpr size_t WS_XB = 64 * MiB, WS_PB = 128 * MiB, WS_PJ = 160 * MiB, WS_MIX = 160 * MiB;
constexpr size_t WS_QA = 224 * MiB, WS_KA = 256 * MiB, WS_VA = 288 * MiB, WS_KB = 320 * MiB, WS_LAT = 368 * MiB, WS_OA = 368 * MiB, WS_LSE = 464 * MiB;
constexpr size_t DO_CQN = 0, DO_CKVN = 24 * MiB, DO_QB = 40 * MiB, DO_VB = 88 * MiB;
constexpr size_t WS_FA = 160 * MiB, WS_FG = 336 * MiB;
constexpr size_t WS_BA = 160 * MiB, WS_BU = 166 * MiB, WS_BC = 172 * MiB;
constexpr size_t WS_QC = 160 * MiB, WS_KC = 224 * MiB, WS_VC = 288 * MiB, WS_O0 = 352 * MiB, WS_MIX1 = 416 * MiB;
constexpr size_t WS_XB2 = 448 * MiB;
constexpr size_t WS_NEED = 512 * MiB;
constexpr int LDS_BYTES = 131072 + 1024;

#define XB_TMO      128
#define XB_XCNT(j)  (256  + 64 * (j))
#define XB_XSUB(j)  (1280 + 64 * (j))
#define XB_XGEN(j)  (2304 + 64 * (j))
#define XB_TOP      3328
#define XB_TOPGEN   3392
#define XCD_BAR_WORDS 3456
#define XB_SPIN_CAP (1u << 18)

__device__ __forceinline__ unsigned xb_ld(unsigned* p)              { return __hip_atomic_load(p, __ATOMIC_RELAXED, __HIP_MEMORY_SCOPE_AGENT); }
__device__ __forceinline__ unsigned xb_add(unsigned* p, unsigned v) { return __hip_atomic_fetch_add(p, v, __ATOMIC_RELAXED, __HIP_MEMORY_SCOPE_AGENT); }
__device__ __forceinline__ unsigned xb_xcc_id() { return (unsigned)__builtin_amdgcn_s_getreg((3 << 11) | 20) & 0xFu; }
#define XB_SPIN(cond, bar) do { unsigned _sp = 0; while (cond) { __builtin_amdgcn_s_sleep(1); \
    if ((++_sp & 255u) == 0u) { if (xb_ld(&(bar)[XB_TMO])) break; if (_sp > XB_SPIN_CAP) { atomicAdd(&(bar)[XB_TMO], 1u); break; } } } } while (0)

struct XcdBarrier {
    unsigned* bar; unsigned x;
    volatile LAS unsigned* st;
};

__device__ __forceinline__ XcdBarrier xcd_barrier_post(unsigned* bar, volatile LAS unsigned* st) {
    XcdBarrier b; b.bar = bar; b.x = xb_xcc_id(); b.st = st;
    if (threadIdx.x == 0) (void)xb_add(&bar[XB_XCNT(b.x)], 1u);
    return b;
}
__device__ __forceinline__ void xcd_barrier_complete(unsigned* bar, unsigned x, unsigned& nloc, unsigned& nx) {
    const unsigned G = gridDim.x * gridDim.y * gridDim.z;
    unsigned sum, cnt, mine, sp = 0u;
    for (;;) {
        sum = 0u; cnt = 0u; mine = 0u;
#pragma unroll
        for (unsigned j = 0; j < 16; ++j) { const unsigned c = xb_ld(&bar[XB_XCNT(j)]); sum += c; cnt += (c > 0u) ? 1u : 0u; mine = (j == x) ? c : mine; }
        if (sum == G) break;
        __builtin_amdgcn_s_sleep(1);
        if ((++sp & 255u) == 0u) { if (xb_ld(&bar[XB_TMO])) break; if (sp > XB_SPIN_CAP) { atomicAdd(&bar[XB_TMO], 1u); break; } }
    }
    nloc = mine > 0u ? mine : 1u; nx = cnt > 0u ? cnt : 1u;
}

__device__ __forceinline__ void xcd_barrier(const XcdBarrier& b) {
    asm volatile("s_waitcnt vmcnt(0)" ::: "memory");
    __syncthreads();
    if (threadIdx.x == 0) {
        unsigned* bar = b.bar;
        __builtin_amdgcn_s_waitcnt(0);
        unsigned nloc = b.st[0], nx = b.st[1];
        if (nloc == 0u) { xcd_barrier_complete(bar, b.x, nloc, nx); b.st[0] = nloc; b.st[1] = nx; }
        const unsigned old = xb_add(&bar[XB_XSUB(b.x)], 1u);
        const unsigned gen = old / nloc;
        if (old + 1u == (gen + 1u) * nloc) {
            __builtin_amdgcn_fence(__ATOMIC_RELEASE, "agent");
            asm volatile("s_waitcnt vmcnt(0)" ::: "memory");
            const unsigned og = xb_add(&bar[XB_TOP], 1u);
            const unsigned tg = og / nx;
            if (og + 1u == (tg + 1u) * nx) xb_add(&bar[XB_TOPGEN], 1u);
            else XB_SPIN(xb_ld(&bar[XB_TOPGEN]) == tg, bar);
            __builtin_amdgcn_fence(__ATOMIC_ACQUIRE, "agent");
            xb_add(&bar[XB_XGEN(b.x)], 1u);
            asm volatile("s_waitcnt vmcnt(0)" ::: "memory");
        } else {
            XB_SPIN(xb_ld(&bar[XB_XGEN(b.x)]) == gen, bar);
            __builtin_amdgcn_fence(__ATOMIC_ACQUIRE, "agent");
            asm volatile("s_waitcnt vmcnt(0)" ::: "memory");
        }
    }
    __syncthreads();
}

__device__ __forceinline__ unsigned cvt_pk(float lo, float hi) { return pg8::cvt_pk_bf16(lo, hi); }
__device__ __forceinline__ float bf_lo(unsigned w) { return __uint_as_float(w << 16); }
__device__ __forceinline__ float bf_hi(unsigned w) { return __uint_as_float(w & 0xffff0000u); }
__device__ __forceinline__ u32x4 pack8(f32x4 a, f32x4 b) { u32x4 w; w.x = cvt_pk(a[0], a[1]); w.y = cvt_pk(a[2], a[3]); w.z = cvt_pk(b[0], b[1]); w.w = cvt_pk(b[2], b[3]); return w; }
__device__ __forceinline__ void unpack8(u32x4 w, f32x4& a, f32x4& b) { a = (f32x4){bf_lo(w.x), bf_hi(w.x), bf_lo(w.y), bf_hi(w.y)}; b = (f32x4){bf_lo(w.z), bf_hi(w.z), bf_lo(w.w), bf_hi(w.w)}; }
__device__ __forceinline__ float fexp2(float x) { return __builtin_amdgcn_exp2f(x); }
__device__ __forceinline__ float wave_sum(float v) {
#pragma unroll
    for (int o = 1; o < 64; o <<= 1) v += __shfl_xor(v, o);
    return v;
}
__device__ __forceinline__ void rope8(f32x4& v0, f32x4& v1, const float* tab) {
    const f32x4 t0 = *(const f32x4*)tab, t1 = *(const GAS f32x4*)(tab + 4);
    float a, b;
    a = v0[0]; b = v0[1]; v0[0] = a * t0[0] - b * t0[1]; v0[1] = b * t0[0] + a * t0[1];
    a = v0[2]; b = v0[3]; v0[2] = a * t0[2] - b * t0[3]; v0[3] = b * t0[2] + a * t0[3];
    a = v1[0]; b = v1[1]; v1[0] = a * t1[0] - b * t1[1]; v1[1] = b * t1[0] + a * t1[1];
    a = v1[2]; b = v1[3]; v1[2] = a * t1[2] - b * t1[3]; v1[3] = b * t1[2] + a * t1[3];
}

__device__ __forceinline__ void row_stats(const float* st, int row, float& mean, float& rstd) {
    const f32x2v s = *(const GAS f32x2v*)(st + 2 * (size_t)row);
    mean = s[0] * (1.f / DM); const float var = s[1] * (1.f / DM) - mean * mean; rstd = 1.f / sqrtf(fmaxf(var, 0.f) + 1e-5f);
}
struct LnCtx { f32x4 cs[2], bw[2]; };
__device__ __forceinline__ void ln_ctx(const float* cs, const float* bw, int c0, LnCtx& c) {
#pragma unroll
    for (int i = 0; i < 2; ++i) { c.cs[i] = *(const GAS f32x4*)(cs + c0 + 4 * i); c.bw[i] = *(const GAS f32x4*)(bw + c0 + 4 * i); }
}
__device__ __forceinline__ void ln_fix(f32x4& v0, f32x4& v1, float mean, float rstd, const LnCtx& c) {
    v0 = (v0 - c.cs[0] * mean) * rstd + c.bw[0]; v1 = (v1 - c.cs[1] * mean) * rstd + c.bw[1];
}
struct NoCtx {};
template <class F> struct Epi8 {
    static constexpr bool PERM = true, AFTER_DRAIN = false; F f;
    __device__ __forceinline__ void operator()(const f32x4 (&acc)[2][2][4][2], const pg8::Unit& u, int wr, int wc, int fr, int fq) const {
        const int row0 = u.pm * 256 + wr * 64 + fr, col0 = u.pn * 256 + wc * 32 + 8 * fq;
#pragma unroll
        for (int bj = 0; bj < 2; ++bj) {
            const int c0 = col0 + bj * 128; typename F::Ctx ctx; f.prep(c0, ctx);
#pragma unroll
            for (int ai = 0; ai < 2; ++ai)
#pragma unroll
                for (int m0 = 0; m0 < 4; m0 += F::NB) {
                    typename F::Tmp tmp[F::NB];
#pragma unroll
                    for (int m = 0; m < F::NB; ++m) f.load(row0 + ai * 128 + (m0 + m) * 16, c0, tmp[m]);
#pragma unroll
                    for (int m = 0; m < F::NB; ++m) f.apply(row0 + ai * 128 + (m0 + m) * 16, c0, acc[ai][bj][m0 + m][0], acc[ai][bj][m0 + m][1], ctx, tmp[m]);
                    asm volatile("" ::: "memory");
                }
        }
    }
};
struct RopeTmp { f32x4 t0, t1; };
__device__ __forceinline__ void rope8t(f32x4& v0, f32x4& v1, const RopeTmp& t) {
    float a, b;
    a = v0[0]; b = v0[1]; v0[0] = a * t.t0[0] - b * t.t0[1]; v0[1] = b * t.t0[0] + a * t.t0[1];
    a = v0[2]; b = v0[3]; v0[2] = a * t.t0[2] - b * t.t0[3]; v0[3] = b * t.t0[2] + a * t.t0[3];
    a = v1[0]; b = v1[1]; v1[0] = a * t.t1[0] - b * t.t1[1]; v1[1] = b * t.t1[0] + a * t.t1[1];
    a = v1[2]; b = v1[3]; v1[2] = a * t.t1[2] - b * t.t1[3]; v1[3] = b * t.t1[2] + a * t.t1[3];
}
__device__ __forceinline__ void rope_ld(RopeTmp& t, const float* tab) { t.t0 = *(const f32x4*)tab; t.t1 = *(const GAS f32x4*)(tab + 4); }
struct FWin { static constexpr int NB = 4;
    typedef NoCtx Ctx; typedef RopeTmp Tmp; bf16_t *QA, *KA, *VA; float* LAT; bf16_t* KB; const float *ropeA, *ropeB;
    __device__ __forceinline__ void prep(int, Ctx&) const {}
    __device__ __forceinline__ void load(int row, int c0, Tmp& t) const {
        if (c0 < 1024) { if ((c0 & 63) < 16) rope_ld(t, ropeA + (size_t)row * 16 + (c0 & 63)); }
        else if (c0 >= 2176 && c0 < 2208) rope_ld(t, ropeB + (size_t)row * 32 + (c0 - 2176));
    }
    __device__ __forceinline__ void apply(int row, int c0, f32x4 v0, f32x4 v1, const Ctx&, const Tmp& t) const {
        if (c0 < 1536) {
            const int sec = c0 >> 9, cc = c0 & 511;
            if (sec < 2 && (cc & 63) < 16) rope8t(v0, v1, t);
            if (sec == 0) { v0 = v0 * QS_A; v1 = v1 * QS_A; }
            bf16_t* dst = (sec == 0 ? QA : (sec == 1 ? KA : VA)) + (size_t)row * 512 + cc;
            *(u32x4*)dst = pack8(v0, v1);
        } else if (c0 < 2176) {
            float* dst = LAT + (size_t)row * 640 + (c0 - 1536);
            *(f32x4*)dst = v0; *(GAS f32x4*)(dst + 4) = v1;
        } else if (c0 < 2208) {
            const int j = c0 - 2176;
            rope8t(v0, v1, t);
            const u32x4 w = pack8(v0, v1);
            bf16_t* dst = KB + (size_t)row * 768 + 64 + j;
#pragma unroll
            for (int h = 0; h < 8; ++h) *(GAS u32x4*)(dst + h * 96) = w;
        }
    }
};
struct FQup { static constexpr int NB = 4;
    typedef NoCtx Ctx; typedef RopeTmp Tmp; bf16_t* QB; const float* ropeB;
    __device__ __forceinline__ void prep(int, Ctx&) const {}
    __device__ __forceinline__ void load(int row, int c0, Tmp& t) const { const int w = c0 % 96; if (w >= 64) rope_ld(t, ropeB + (size_t)row * 32 + (w - 64)); }
    __device__ __forceinline__ void apply(int row, int c0, f32x4 v0, f32x4 v1, const Ctx&, const Tmp& t) const {
        const int w = c0 % 96;
        if (w >= 64) rope8t(v0, v1, t);
        v0 = v0 * QS_B; v1 = v1 * QS_B;
        *(GAS u32x4*)(QB + (size_t)row * 768 + c0) = pack8(v0, v1);
    }
};
struct FKvup { static constexpr int NB = 4;
    typedef NoCtx Ctx; typedef NoCtx Tmp; bf16_t *KB, *VB;
    __device__ __forceinline__ void prep(int, Ctx&) const {}
    __device__ __forceinline__ void load(int, int, Tmp&) const {}
    __device__ __forceinline__ void apply(int row, int c0, f32x4 v0, f32x4 v1, const Ctx&, const Tmp&) const {
        const u32x4 w = pack8(v0, v1);
        if (c0 < 512) *(GAS u32x4*)(KB + (size_t)row * 768 + (c0 >> 6) * 96 + (c0 & 63)) = w;
        else *(GAS u32x4*)(VB + (size_t)row * 512 + (c0 - 512)) = w;
    }
};
struct FBf16 { static constexpr int NB = 4;
    typedef NoCtx Ctx; typedef NoCtx Tmp; bf16_t* O; int ld;
    __device__ __forceinline__ void prep(int, Ctx&) const {}
    __device__ __forceinline__ void load(int, int, Tmp&) const {}
    __device__ __forceinline__ void apply(int row, int c0, f32x4 v0, f32x4 v1, const Ctx&, const Tmp&) const { *(GAS u32x4*)(O + (size_t)row * ld + c0) = pack8(v0, v1); }
};
__device__ __forceinline__ float gelu_tanh(float c) {
    constexpr float GA = -2.0f * LOG2E * 0.7978845608028654f, GB = GA * 0.044715f;
    return c * __builtin_amdgcn_rcpf(1.0f + fexp2(c * __builtin_fmaf(GB, c * c, GA)));
}
struct StTmp { f32x2v s; };
__device__ __forceinline__ void st_decode(const StTmp& t, float& mean, float& rstd) {
    mean = t.s[0] * (1.f / DM); const float var = t.s[1] * (1.f / DM) - mean * mean; rstd = 1.f / sqrtf(fmaxf(var, 0.f) + 1e-5f);
}
struct FGateLn { static constexpr int NB = 4;
    typedef LnCtx Ctx; typedef StTmp Tmp; bf16_t* O; const float* st; const float* cs; const float* bw;
    __device__ __forceinline__ void prep(int c0, Ctx& c) const { ln_ctx(cs, bw, c0, c); }
    __device__ __forceinline__ void load(int row, int, Tmp& t) const { t.s = *(const GAS f32x2v*)(st + 2 * (size_t)row); }
    __device__ __forceinline__ void apply(int row, int c0, f32x4 v0, f32x4 v1, const Ctx& c, const Tmp& t) const {
        float mean, rstd; st_decode(t, mean, rstd); ln_fix(v0, v1, mean, rstd, c);
        *(GAS u32x4*)(O + (size_t)row * DFF + c0) = pack8(v0, v1);
    }
};
struct FUpConv { static constexpr int NB = 1;
    struct Ctx { f32x4 w0[2], w1[2], w2[2], b[2]; LnCtx ln; };
    struct Tmp { f32x2v s; u32x4 wm, w0, wp; };
    const bf16_t* A; bf16_t* Gout; const float* cw; const float* cb; const float* st; const float* cs; const float* bw;
    __device__ __forceinline__ void prep(int c0, Ctx& c) const {
        ln_ctx(cs, bw, c0, c.ln);
#pragma unroll
        for (int i = 0; i < 2; ++i) { c.w0[i] = *(const GAS f32x4*)(cw + c0 + 4 * i); c.w1[i] = *(const GAS f32x4*)(cw + DFF + c0 + 4 * i); c.w2[i] = *(const GAS f32x4*)(cw + 2 * DFF + c0 + 4 * i); c.b[i] = *(const GAS f32x4*)(cb + c0 + 4 * i); }
    }
    __device__ __forceinline__ void load(int row, int c0, Tmp& t) const {
        const int tt = row & (SEQ - 1);
        const bf16_t* ap = A + (size_t)row * DFF + c0;
        const u32x4 z = (u32x4){0u, 0u, 0u, 0u};
        t.s = *(const GAS f32x2v*)(st + 2 * (size_t)row);
        t.wm = tt > 0 ? *(const GAS u32x4*)(ap - DFF) : z; t.w0 = *(const u32x4*)ap; t.wp = tt < SEQ - 1 ? *(const GAS u32x4*)(ap + DFF) : z;
    }
    __device__ __forceinline__ void apply(int row, int c0, f32x4 v0, f32x4 v1, const Ctx& c, const Tmp& t) const {
        { StTmp s{t.s}; float mean, rstd; st_decode(s, mean, rstd); ln_fix(v0, v1, mean, rstd, c.ln); }
        f32x4 am0, am1, a00, a01, ap0, ap1; unpack8(t.wm, am0, am1); unpack8(t.w0, a00, a01); unpack8(t.wp, ap0, ap1);
        f32x4 c0v = c.b[0] + c.w0[0] * am0 + c.w1[0] * a00 + c.w2[0] * ap0;
        f32x4 c1v = c.b[1] + c.w0[1] * am1 + c.w1[1] * a01 + c.w2[1] * ap1;
#pragma unroll
        for (int e = 0; e < 4; ++e) { c0v[e] = gelu_tanh(c0v[e]) * v0[e]; c1v[e] = gelu_tanh(c1v[e]) * v1[e]; }
        *(GAS u32x4*)(Gout + (size_t)row * DFF + c0) = pack8(c0v, c1v);
    }
};
#ifndef UPC_SCHED
#define UPC_SCHED 2
#endif
struct EpiUpConv {
    static constexpr bool PERM = true, AFTER_DRAIN = false; FUpConv f;
    template <int NB> __device__ __forceinline__ void batch(const f32x4 (&acc)[2][2][4][2], int ai, int bj, int m0, int row0, int c0, const FUpConv::Ctx& ctx) const {
        FUpConv::Tmp tmp[NB];
#pragma unroll
        for (int m = 0; m < NB; ++m) f.load(row0 + ai * 128 + (m0 + m) * 16, c0, tmp[m]);
#pragma unroll
        for (int m = 0; m < NB; ++m) f.apply(row0 + ai * 128 + (m0 + m) * 16, c0, acc[ai][bj][m0 + m][0], acc[ai][bj][m0 + m][1], ctx, tmp[m]);
        asm volatile("" ::: "memory");
    }
    __device__ __forceinline__ void operator()(const f32x4 (&acc)[2][2][4][2], const pg8::Unit& u, int wr, int wc, int fr, int fq) const {
        const int row0 = u.pm * 256 + wr * 64 + fr, col0 = u.pn * 256 + wc * 32 + 8 * fq;
        { FUpConv::Ctx ctx; f.prep(col0, ctx);
#if UPC_SCHED == 1
          batch<1>(acc, 0, 0, 0, row0, col0, ctx); batch<1>(acc, 0, 0, 1, row0, col0, ctx); batch<1>(acc, 0, 0, 2, row0, col0, ctx); batch<1>(acc, 0, 0, 3, row0, col0, ctx);
          batch<2>(acc, 1, 0, 0, row0, col0, ctx); batch<2>(acc, 1, 0, 2, row0, col0, ctx);
#elif UPC_SCHED == 2
          batch<1>(acc, 0, 0, 0, row0, col0, ctx); batch<1>(acc, 0, 0, 1, row0, col0, ctx); batch<2>(acc, 0, 0, 2, row0, col0, ctx);
          batch<2>(acc, 1, 0, 0, row0, col0, ctx); batch<2>(acc, 1, 0, 2, row0, col0, ctx);
#else
          batch<1>(acc, 0, 0, 0, row0, col0, ctx); batch<1>(acc, 0, 0, 1, row0, col0, ctx); batch<2>(acc, 0, 0, 2, row0, col0, ctx);
          batch<4>(acc, 1, 0, 0, row0, col0, ctx);
#endif
        }
        { FUpConv::Ctx ctx; f.prep(col0 + 128, ctx);
          batch<4>(acc, 0, 1, 0, row0, col0 + 128, ctx); batch<4>(acc, 1, 1, 0, row0, col0 + 128, ctx); }
    }
};
#define DPP_SHR1(keep, x) __int_as_float(__builtin_amdgcn_update_dpp(__float_as_int(keep), __float_as_int(x), 0x111, 0xf, 0xf, false))
#define DPP_SHL1(keep, x) __int_as_float(__builtin_amdgcn_update_dpp(__float_as_int(keep), __float_as_int(x), 0x101, 0xf, 0xf, false))
#define DPP_ROR1(x) __int_as_float(__builtin_amdgcn_update_dpp(0, __float_as_int(x), 0x121, 0xf, 0xf, false))
#define DPP_ROL1(x) __int_as_float(__builtin_amdgcn_update_dpp(0, __float_as_int(x), 0x12F, 0xf, 0xf, false))
struct EpiGateUp {
    static constexpr bool PERM = true, AFTER_DRAIN = false;
    bf16_t* Gout; bf16_t* BA; bf16_t* BU; float* BC; const float* cw; const float* cb; const float* st; const float* vec;
    __device__ __forceinline__ void operator()(const f32x4 (&acc)[2][2][4][2], const pg8::Unit& u, int wr, int wc, int fr, int fq) const {
        const int row0 = u.pm * 256 + wr * 64 + fr, hc = u.pn * 128 + wc * 32 + 8 * fq;
        float mean_[2][4], rstd_[2][4];
#pragma unroll
        for (int ai = 0; ai < 2; ++ai)
#pragma unroll
            for (int m = 0; m < 4; ++m) { StTmp s; s.s = *(const GAS f32x2v*)(st + 2 * (size_t)(row0 + ai * 128 + m * 16)); st_decode(s, mean_[ai][m], rstd_[ai][m]); }
#pragma unroll
        for (int h = 0; h < 2; ++h) {
            const int c4 = hc + 4 * h;
            const f32x4 csG = *(const GAS f32x4*)(vec + V_CSG + c4), bwG = *(const GAS f32x4*)(vec + V_BWG + c4), csU = *(const GAS f32x4*)(vec + V_CSU + c4), bwU = *(const GAS f32x4*)(vec + V_BWU + c4);
            const f32x4 w0 = *(const GAS f32x4*)(cw + c4), w1 = *(const GAS f32x4*)(cw + DFF + c4), w2 = *(const GAS f32x4*)(cw + 2 * DFF + c4), bb = *(const GAS f32x4*)(cb + c4);
#pragma unroll
            for (int ai = 0; ai < 2; ++ai) {
                f32x4 af[4], uf[4];
#pragma unroll
                for (int m = 0; m < 4; ++m) {
                    const float mean = mean_[ai][m], rstd = rstd_[ai][m];
                    af[m] = (acc[ai][0][m][h] - csG * mean) * rstd + bwG; uf[m] = (acc[ai][1][m][h] - csU * mean) * rstd + bwU;
                }
#pragma unroll
                for (int m = 0; m < 4; ++m) {
                    f32x4 pv, nx;
#pragma unroll
                    for (int e = 0; e < 4; ++e) {
                        const float keepP = m > 0 ? DPP_ROR1(af[m > 0 ? m - 1 : 0][e]) : 0.f; pv[e] = DPP_SHR1(keepP, af[m][e]);
                        const float keepN = m < 3 ? DPP_ROL1(af[m < 3 ? m + 1 : 3][e]) : 0.f; nx[e] = DPP_SHL1(keepN, af[m][e]);
                    }
                    f32x4 c = bb + w0 * pv + w1 * af[m] + w2 * nx;
                    const int row = row0 + ai * 128 + m * 16;
                    const bool defer = (m == 0 && fr == 0) || (m == 3 && fr == 15);
                    if (!defer) {
#pragma unroll
                        for (int e = 0; e < 4; ++e) c[e] = gelu_tanh(c[e]) * uf[m][e];
                        u32x2v w; w.x = cvt_pk(c[0], c[1]); w.y = cvt_pk(c[2], c[3]);
                        *(GAS u32x2v*)(Gout + (size_t)row * DFF + c4) = w;
                    } else {
                        const size_t bo = (size_t)(2 * (row >> 6) + (m == 3 ? 1 : 0)) * DFF + c4;
                        u32x2v wa, wu; wa.x = cvt_pk(af[m][0], af[m][1]); wa.y = cvt_pk(af[m][2], af[m][3]); wu.x = cvt_pk(uf[m][0], uf[m][1]); wu.y = cvt_pk(uf[m][2], uf[m][3]);
                        *(GAS u32x2v*)(BA + bo) = wa; *(GAS u32x2v*)(BU + bo) = wu; *(GAS f32x4*)(BC + bo) = c;
                    }
                }
            }
        }
    }
};
__device__ __forceinline__ void ffn_fixup_phase(bf16_t* __restrict__ G, const bf16_t* __restrict__ BA, const bf16_t* __restrict__ BU, const float* __restrict__ BC, const float* __restrict__ cw, int gt, int NTH) {
    for (int idx = gt; idx < (M / 32) * (DFF / 4); idx += NTH) {
        const int brow = idx / (DFF / 4), c4 = (idx % (DFF / 4)) * 4, r = 64 * (brow >> 1) + 63 * (brow & 1);
        const size_t bo = (size_t)brow * DFF + c4;
        f32x4 c = *(const GAS f32x4*)(BC + bo); const u32x2v wu = *(const GAS u32x2v*)(BU + bo);
        const bool lo = (brow & 1) == 0; const bool edge = lo ? (r & (SEQ - 1)) == 0 : (r & (SEQ - 1)) == SEQ - 1;
        if (!edge) { const u32x2v wa = *(const GAS u32x2v*)(BA + (lo ? bo - DFF : bo + DFF)); const f32x4 wt = *(const GAS f32x4*)(cw + (lo ? 0 : 2 * DFF) + c4);
            c[0] += wt[0] * bf_lo(wa.x); c[1] += wt[1] * bf_hi(wa.x); c[2] += wt[2] * bf_lo(wa.y); c[3] += wt[3] * bf_hi(wa.y); }
        u32x2v w; w.x = cvt_pk(gelu_tanh(c[0]) * bf_lo(wu.x), gelu_tanh(c[1]) * bf_hi(wu.x)); w.y = cvt_pk(gelu_tanh(c[2]) * bf_lo(wu.y), gelu_tanh(c[3]) * bf_hi(wu.y));
        *(GAS u32x2v*)(G + (size_t)r * DFF + c4) = w;
    }
}
struct FPle { static constexpr int NB = 2;
    struct Ctx { LnCtx ln; f32x4 g[2], b[2]; };
    struct Tmp { f32x2v s; u32x4 xb; u32x4 pj; };
    float* XF; const bf16_t* XBi; const bf16_t* PJ; bf16_t* XBo; const float* st; const float* cs; const float* bw; const float* lg; const float* lb;
    __device__ __forceinline__ void prep(int c0, Ctx& c) const {
        ln_ctx(cs, bw, c0, c.ln);
#pragma unroll
        for (int i = 0; i < 2; ++i) { c.g[i] = *(const GAS f32x4*)(lg + c0 + 4 * i); c.b[i] = *(const GAS f32x4*)(lb + c0 + 4 * i); }
    }
    __device__ __forceinline__ void load(int row, int c0, Tmp& t) const {
        const size_t o = (size_t)row * DM + c0;
        t.s = *(const GAS f32x2v*)(st + 2 * (size_t)row); t.xb = *(const GAS u32x4*)(XBi + o); t.pj = *(const GAS u32x4*)(PJ + o);
    }
    __device__ __forceinline__ void apply(int row, int c0, f32x4 v0, f32x4 v1, const Ctx& c, const Tmp& t) const {
        StTmp s{t.s}; float mean, rstd; st_decode(s, mean, rstd); ln_fix(v0, v1, mean, rstd, c.ln);
        const size_t o = (size_t)row * DM + c0;
        f32x4 x0, x1, p0, p1; unpack8(t.xb, x0, x1); unpack8(t.pj, p0, p1);
        x0 = (x0 - mean) * rstd * c.g[0] + c.b[0]; x1 = (x1 - mean) * rstd * c.g[1] + c.b[1];
#pragma unroll
        for (int e = 0; e < 4; ++e) { x0[e] += p0[e] * __builtin_amdgcn_rcpf(1.0f + fexp2(-LOG2E * v0[e])); x1[e] += p1[e] * __builtin_amdgcn_rcpf(1.0f + fexp2(-LOG2E * v1[e])); }
        if (XF) { *(GAS f32x4*)(XF + o) = x0; *(GAS f32x4*)(XF + o + 4) = x1; } if (XBo) *(GAS u32x4*)(XBo + o) = pack8(x0, x1);
    }
};
struct FCqkv { static constexpr int NB = 4;
    typedef NoCtx Ctx; typedef RopeTmp Tmp; bf16_t *Q, *K, *V; const float* ropeA;
    __device__ __forceinline__ void prep(int, Ctx&) const {}
    __device__ __forceinline__ void load(int row, int c0, Tmp& t) const { if (c0 < 2048 && (c0 & 63) < 16) rope_ld(t, ropeA + (size_t)row * 16 + (c0 & 63)); }
    __device__ __forceinline__ void apply(int row, int c0, f32x4 v0, f32x4 v1, const Ctx&, const Tmp& t) const {
        const int sec = c0 >> 10, cc = c0 & 1023;
        if (sec < 2 && (cc & 63) < 16) rope8t(v0, v1, t);
        if (sec == 0) { v0 = v0 * QS_C; v1 = v1 * QS_C; }
        bf16_t* dst = (sec == 0 ? Q : (sec == 1 ? K : V)) + (size_t)row * 1024 + cc;
        *(u32x4*)dst = pack8(v0, v1);
    }
};
template <bool LNRES> struct EpiResidStat {
    static constexpr bool PERM = true, AFTER_DRAIN = false;
    const float* res; const float* pst; const float* pg; const float* pb; bf16_t* xb; float* st; const bf16_t* resb;
    __device__ __forceinline__ void operator()(const f32x4 (&acc)[2][2][4][2], const pg8::Unit& u, int wr, int wc, int fr, int fq) const {
        const int row0 = u.pm * 256 + wr * 64 + fr, col0 = u.pn * 256 + wc * 32 + 8 * fq;
        f32x4 g[2][2], b[2][2];
        if (LNRES) {
#pragma unroll
            for (int bj = 0; bj < 2; ++bj)
#pragma unroll
                for (int i = 0; i < 2; ++i) { g[bj][i] = *(const GAS f32x4*)(pg + col0 + 128 * bj + 4 * i); b[bj][i] = *(const GAS f32x4*)(pb + col0 + 128 * bj + 4 * i); }
        }
        constexpr int NB = LNRES ? 2 : 4;
#pragma unroll
        for (int aim = 0; aim < 8; aim += NB) {
            const int ai = aim >> 2, mb = aim & 3;
            f32x4 r[LNRES ? 1 : NB][2][2]; u32x4 rb[LNRES ? NB : 1][2]; f32x2v sv[NB];
#pragma unroll
            for (int mm = 0; mm < NB; ++mm) {
                const int m = mb + mm; const int row = row0 + ai * 128 + m * 16;
                if (LNRES) sv[mm] = *(const GAS f32x2v*)(pst + 2 * (size_t)row);
#pragma unroll
                for (int bj = 0; bj < 2; ++bj) { const size_t o = (size_t)row * DM + col0 + 128 * bj;
                    if (LNRES) rb[LNRES ? mm : 0][bj] = *(const GAS u32x4*)(xb + o);
                    else if (resb) { const u32x4 w_ = *(const GAS u32x4*)(resb + o); unpack8(w_, r[LNRES ? 0 : mm][bj][0], r[LNRES ? 0 : mm][bj][1]); }
                    else { r[LNRES ? 0 : mm][bj][0] = *(const GAS f32x4*)(res + o); r[LNRES ? 0 : mm][bj][1] = *(const GAS f32x4*)(res + o + 4); } }
            }
#pragma unroll
            for (int mm = 0; mm < NB; ++mm) {
                const int m = mb + mm; const int row = row0 + ai * 128 + m * 16;
                float mean = 0.f, rstd = 1.f; if (LNRES) { StTmp s{sv[mm]}; st_decode(s, mean, rstd); }
                float s = 0.f, ss = 0.f;
#pragma unroll
                for (int bj = 0; bj < 2; ++bj) {
                    const size_t o = (size_t)row * DM + col0 + 128 * bj;
                    f32x4 r0, r1;
                    if (LNRES) { unpack8(rb[LNRES ? mm : 0][bj], r0, r1); r0 = (r0 - mean) * rstd * g[bj][0] + b[bj][0]; r1 = (r1 - mean) * rstd * g[bj][1] + b[bj][1]; }
                    else { r0 = r[LNRES ? 0 : mm][bj][0]; r1 = r[LNRES ? 0 : mm][bj][1]; }
                    const f32x4 v0 = r0 * ALPHA + acc[ai][bj][m][0], v1 = r1 * ALPHA + acc[ai][bj][m][1];
                    *(GAS u32x4*)(xb + o) = pack8(v0, v1);
                    s += (v0[0] + v0[1]) + (v0[2] + v0[3]) + (v1[0] + v1[1]) + (v1[2] + v1[3]);
                    ss += (v0[0] * v0[0] + v0[1] * v0[1]) + (v0[2] * v0[2] + v0[3] * v0[3]) + (v1[0] * v1[0] + v1[1] * v1[1]) + (v1[2] * v1[2] + v1[3] * v1[3]);
                }
                s += __shfl_xor(s, 16); s += __shfl_xor(s, 32); ss += __shfl_xor(ss, 16); ss += __shfl_xor(ss, 32);
                if (fq == 0) { __builtin_amdgcn_global_atomic_fadd_f32((GAS float*)(st + 2 * (size_t)row), s); __builtin_amdgcn_global_atomic_fadd_f32((GAS float*)(st + 2 * (size_t)row + 1), ss); }
            }
            asm volatile("" ::: "memory");
        }
    }
};
template <class E> __device__ __forceinline__ void run_gemm_e(LAS unsigned char* lds, const bf16_t* A, const bf16_t* Bt, int N, int K, int G, const E& e) {
    pg8::Gemm g{A, Bt, M, N, K}; pg8::StaticOrder S; S.init(M, N, G, (int)blockIdx.x);
    pg8::gemm_phase<E, pg8::StaticOrder, true, true>(lds, g, S, e);
}
__device__ __forceinline__ void colvec_item(const float* __restrict__ W, int ldw, int n0, const float* __restrict__ g, const float* __restrict__ b, float* cs, float* bw, LAS float* red, int wave, int lane) {
    float s0 = 0.f, s1 = 0.f;
#pragma unroll 16
    for (int k = wave * 128; k < wave * 128 + 128; ++k) { const float w = W[(size_t)k * ldw + n0 + lane]; s0 += bf_lo(cvt_pk(w * g[k], 0.f)); s1 += w * b[k]; }
    red[(wave * 64 + lane) * 2] = s0; red[(wave * 64 + lane) * 2 + 1] = s1;
    __syncthreads();
    if (wave == 0) { float t0 = 0.f, t1 = 0.f;
#pragma unroll
        for (int w = 0; w < 8; ++w) { t0 += red[(w * 64 + lane) * 2]; t1 += red[(w * 64 + lane) * 2 + 1]; }
        cs[n0 + lane] = t0; bw[n0 + lane] = t1; }
    __syncthreads();
}
template <class F> __device__ __forceinline__ void run_gemm(LAS unsigned char* lds, const bf16_t* A, const bf16_t* Bt, int N, int K, int G, const F& f) {
    pg8::Gemm g{A, Bt, M, N, K}; pg8::StaticOrder S; S.init(M, N, G, (int)blockIdx.x);
    Epi8<F> E{f};
    pg8::gemm_phase<Epi8<F>, pg8::StaticOrder, true, true>(lds, g, S, E);
}

struct MapId { __device__ __forceinline__ int operator()(int n) const { return n; } };
__device__ __forceinline__ int il16(int w) { return (w & 1) ? 8 + (w >> 1) : (w >> 1); }
__device__ __forceinline__ int il32(int w) { return (w & 1) ? 16 + (w >> 1) : (w >> 1); }
struct MapRope64 { int lim; __device__ __forceinline__ int operator()(int n) const { if (n < lim) { const int w = n & 63; if (w < 16) return (n - w) + il16(w); } return n; } };
struct MapWin { __device__ __forceinline__ int operator()(int n) const {
    if (n < 1024) { const int w = n & 63; return w < 16 ? (n - w) + il16(w) : n; }
    if (n < 2176) return n;
    if (n < 2208) return 2176 + il32(n - 2176);
    return -1; } };
struct MapQup { __device__ __forceinline__ int operator()(int n) const { const int w = n % 96; return w >= 64 ? (n - w) + 64 + il32(w - 64) : n; } };
struct MapKvup { __device__ __forceinline__ int operator()(int n) const { if (n < 512) return (n >> 6) * 128 + (n & 63); const int m = n - 512; return (m >> 6) * 128 + 64 + (m & 63); } };
template <class Map> __device__ __forceinline__ void prep_item(const float* __restrict__ W, int K, int ldw, bf16_t* __restrict__ WT, int Nout, Map map, LAS float* scr, int it, int lane,
                                                               const float* __restrict__ gain = nullptr, const float* __restrict__ bias = nullptr, float* pcs = nullptr, float* pbw = nullptr, int rowmap = 0) {
    const int nblk = Nout / 32;
    const int kb = it / nblk, nb = it % nblk, k0 = 64 * kb, n0 = 32 * nb;
    const int rb = rowmap == 0 ? n0 : 256 * (n0 >> 7) + (n0 & 127) + (rowmap == 2 ? 128 : 0);
    const int src = map(n0 + (lane & 31));
    float wv[32];
#pragma unroll
    for (int i = 0; i < 32; ++i) { const int kk = 2 * i + (lane >> 5); wv[i] = src >= 0 ? W[(size_t)(k0 + kk) * ldw + src] : 0.f; }
    if (gain) {
        float s0 = 0.f, s1 = 0.f;
#pragma unroll
        for (int i = 0; i < 32; ++i) { const int kk = 2 * i + (lane >> 5); const float w = wv[i]; s1 += w * bias[k0 + kk]; wv[i] = w * gain[k0 + kk]; s0 += bf_lo(cvt_pk(wv[i], 0.f)); }
        s0 += __shfl_xor(s0, 32); s1 += __shfl_xor(s1, 32);
        if (lane < 32) { pcs[(size_t)kb * VEC_L + n0 + lane] = s0; pbw[(size_t)kb * VEC_L + n0 + lane] = s1; }
    }
#pragma unroll
    for (int i = 0; i < 32; ++i) { const int kk = 2 * i + (lane >> 5); scr[kk * 33 + (lane & 31)] = wv[i]; }
    asm volatile("s_waitcnt lgkmcnt(0)" ::: "memory");
    const int c = lane & 7;
#pragma unroll
    for (int j = 0; j < 4; ++j) { const int n = (lane >> 3) + 8 * j; const LAS float* s = scr + (8 * c) * 33 + n;
        u32x4 o; o.x = cvt_pk(s[0 * 33], s[1 * 33]); o.y = cvt_pk(s[2 * 33], s[3 * 33]); o.z = cvt_pk(s[4 * 33], s[5 * 33]); o.w = cvt_pk(s[6 * 33], s[7 * 33]);
        *(GAS u32x4*)(WT + (size_t)(rb + n) * K + k0 + 8 * c) = o; }
    asm volatile("s_waitcnt lgkmcnt(0)" ::: "memory");
}

__device__ __forceinline__ void ln_phase(float* XF, bf16_t* XB, const float* __restrict__ g, const float* __restrict__ b, int gw, int NGW, int lane) {
    f32x4 gv[4], bv[4];
#pragma unroll
    for (int j = 0; j < 4; ++j) { gv[j] = ((const f32x4*)g)[lane + 64 * j]; bv[j] = ((const f32x4*)b)[lane + 64 * j]; }
    for (int row = gw; row < M; row += NGW) {
        f32x4* xr = (f32x4*)(XF + (size_t)row * DM) + lane;
        f32x4 v[4]; float s = 0.f;
#pragma unroll
        for (int j = 0; j < 4; ++j) { v[j] = xr[64 * j]; s += (v[j][0] + v[j][1]) + (v[j][2] + v[j][3]); }
        const float mean = wave_sum(s) * (1.f / DM); float s2 = 0.f;
#pragma unroll
        for (int j = 0; j < 4; ++j) { v[j] = v[j] - mean; s2 += (v[j][0] * v[j][0] + v[j][1] * v[j][1]) + (v[j][2] * v[j][2] + v[j][3] * v[j][3]); }
        const float rstd = 1.f / sqrtf(wave_sum(s2) * (1.f / DM) + 1e-5f);
        u32x2v* ob = (u32x2v*)(XB + (size_t)row * DM) + lane;
#pragma unroll
        for (int j = 0; j < 4; ++j) { const f32x4 y = v[j] * rstd * gv[j] + bv[j]; xr[64 * j] = y; u32x2v w; w.x = cvt_pk(y[0], y[1]); w.y = cvt_pk(y[2], y[3]); ob[64 * j] = w; }
    }
}
__device__ __forceinline__ void latnorm_phase(const float* __restrict__ LAT, bf16_t* __restrict__ CQN, bf16_t* __restrict__ CKVN, const float* __restrict__ qn, const float* __restrict__ kvn, int gw, int NGW, int lane) {
    f32x2v gq[3];
#pragma unroll
    for (int j = 0; j < 3; ++j) gq[j] = *(const GAS f32x2v*)(qn + 2 * lane + 128 * j);
    const f32x4 gk = *(const GAS f32x4*)(kvn + 4 * lane);
    for (int row = gw; row < M; row += NGW) {
        const float* lr = LAT + (size_t)row * 640;
        f32x2v q[3]; float s = 0.f;
#pragma unroll
        for (int j = 0; j < 3; ++j) { q[j] = *(const GAS f32x2v*)(lr + 2 * lane + 128 * j); s += q[j][0] * q[j][0] + q[j][1] * q[j][1]; }
        const f32x4 kv = *(const GAS f32x4*)(lr + 384 + 4 * lane);
        float s2 = (kv[0] * kv[0] + kv[1] * kv[1]) + (kv[2] * kv[2] + kv[3] * kv[3]);
        const float rq = 1.f / sqrtf(wave_sum(s) * (1.f / 384.f) + 1e-6f), rk = 1.f / sqrtf(wave_sum(s2) * (1.f / 256.f) + 1e-6f);
#pragma unroll
        for (int j = 0; j < 3; ++j) *(GAS unsigned*)(CQN + (size_t)row * 384 + 2 * lane + 128 * j) = cvt_pk(q[j][0] * rq * gq[j][0], q[j][1] * rq * gq[j][1]);
        u32x2v w; w.x = cvt_pk(kv[0] * rk * gk[0], kv[1] * rk * gk[1]); w.y = cvt_pk(kv[2] * rk * gk[2], kv[3] * rk * gk[3]);
        *(GAS u32x2v*)(CKVN + (size_t)row * 256 + 4 * lane) = w;
    }
}
__device__ __forceinline__ void merge_phase(const bf16_t* __restrict__ OA, const float* __restrict__ LSE, bf16_t* __restrict__ MIX, int gw, int NGW, int lane) {
    for (int row = gw; row < M; row += NGW) {
        const int h = lane >> 3;
        const float l0 = LSE[((size_t)0 * M + row) * 8 + h], l1 = LSE[((size_t)1 * M + row) * 8 + h], l2 = LSE[((size_t)2 * M + row) * 8 + h];
        const float mx = fmaxf(l0, fmaxf(l1, l2));
        float w0 = fexp2(l0 - mx), w1 = fexp2(l1 - mx), w2 = fexp2(l2 - mx); const float inv = 1.f / (w0 + w1 + w2); w0 *= inv; w1 *= inv; w2 *= inv;
        f32x4 a0, a1, b0, b1, c0, c1;
        unpack8(*(const GAS u32x4*)(OA + ((size_t)0 * M + row) * 512 + 8 * lane), a0, a1);
        unpack8(*(const GAS u32x4*)(OA + ((size_t)1 * M + row) * 512 + 8 * lane), b0, b1);
        unpack8(*(const GAS u32x4*)(OA + ((size_t)2 * M + row) * 512 + 8 * lane), c0, c1);
        *(GAS u32x4*)(MIX + (size_t)row * 1024 + 8 * lane) = pack8(a0 * w0 + b0 * w1 + c0 * w2, a1 * w0 + b1 * w1 + c1 * w2);
    }
}
__device__ __forceinline__ void diffcomb_phase(const bf16_t* __restrict__ O01, bf16_t* __restrict__ MIX, const float* __restrict__ lamp, const float* __restrict__ subln, int gw, int NGW, int lane) {
    const float s01 = wave_sum(lamp[lane] * lamp[64 + lane]), s23 = wave_sum(lamp[128 + lane] * lamp[192 + lane]);
    const float lam = expf(s01) - expf(s23) + LAMBDA_INIT;
    const int h = lane >> 3, d0 = (lane & 7) * 16;
    f32x4 gsub[4];
#pragma unroll
    for (int j = 0; j < 4; ++j) gsub[j] = *(const GAS f32x4*)(subln + d0 + 4 * j) * (1.0f - LAMBDA_INIT);
    for (int row = gw; row < M; row += NGW) {
        const bf16_t* p0 = O01 + (size_t)row * 2048 + (2 * h) * 128 + d0; const bf16_t* p1 = p0 + 128;
        f32x4 a[4], b[4];
        unpack8(*(const u32x4*)p0, a[0], a[1]); unpack8(*(const GAS u32x4*)(p0 + 8), a[2], a[3]);
        unpack8(*(const u32x4*)p1, b[0], b[1]); unpack8(*(const GAS u32x4*)(p1 + 8), b[2], b[3]);
        float ss = 0.f;
#pragma unroll
        for (int j = 0; j < 4; ++j) { a[j] = a[j] - b[j] * lam; ss += (a[j][0] * a[j][0] + a[j][1] * a[j][1]) + (a[j][2] * a[j][2] + a[j][3] * a[j][3]); }
        ss += __shfl_xor(ss, 1); ss += __shfl_xor(ss, 2); ss += __shfl_xor(ss, 4);
        const float r = 1.f / sqrtf(ss * (1.f / 128.f) + 1e-5f);
#pragma unroll
        for (int j = 0; j < 4; ++j) a[j] = a[j] * r * gsub[j];
        bf16_t* o = MIX + (size_t)row * 1024 + h * 128 + d0;
        *(u32x4*)o = pack8(a[0], a[1]); *(GAS u32x4*)(o + 8) = pack8(a[2], a[3]);
    }
}

__device__ __forceinline__ bf16x8 tr2(const LAS unsigned char* p0, const LAS unsigned char* p1) {
    const v4i16_t a = __builtin_amdgcn_ds_read_tr16_b64_v4i16((LAS v4i16_t*)p0), b = __builtin_amdgcn_ds_read_tr16_b64_v4i16((LAS v4i16_t*)p1);
    return (bf16x8){a[0], a[1], a[2], a[3], b[0], b[1], b[2], b[3]};
}
__device__ __forceinline__ bf16x8 packp(const f32x16& p, int b) {
    u32x4 w; w.x = cvt_pk(p[b], p[b + 1]); w.y = cvt_pk(p[b + 2], p[b + 3]); w.z = cvt_pk(p[b + 4], p[b + 5]); w.w = cvt_pk(p[b + 6], p[b + 7]);
    return __builtin_bit_cast(bf16x8, w);
}
template <int DQ, int DV, int MODE>
__device__ __forceinline__ void attn_dense_unit(LAS unsigned char* lds, const bf16_t* __restrict__ Qp, int ldq, const bf16_t* __restrict__ Kp, int ldk,
                                                const bf16_t* __restrict__ Vp, int ldv, bf16_t* Op, int ldo, int tid,
                                                const bf16_t* O0p = nullptr, int ldo0 = 0, float lam = 0.f, const float* __restrict__ gsub = nullptr) {
    constexpr int KS = DQ + 8, VS = (DV == 64) ? 96 : 160;
    constexpr int KBUF = 64 * KS * 2, VBUF = 64 * VS * 2;
    constexpr int CK = DQ / 8, CV = DV / 8, NKC = 64 * CK, NVC = 64 * CV, NKL = (NKC + 511) / 512, NVL = (NVC + 511) / 512, NT = SEQ / 64, ND = DV / 32;
    const int lane = tid & 63, wave = tid >> 6, r32 = lane & 31, hi = lane >> 5;
    int kgo[NKL], klo[NKL], vgo[NVL], vlo[NVL];
#pragma unroll
    for (int i = 0; i < NKL; ++i) { const int id = tid + 512 * i, row = id / CK, ch = id % CK; kgo[i] = row * ldk + ch * 8; klo[i] = row * KS * 2 + ch * 16; }
#pragma unroll
    for (int i = 0; i < NVL; ++i) { const int id = tid + 512 * i, row = id / CV, ch = id % CV; vgo[i] = row * ldv + ch * 8; vlo[i] = 2 * KBUF + row * VS * 2 + ch * 16; }
    u32x4 kreg[2][NKL], vreg[2][NVL];
#define ATT_LOAD(t, S) do { _Pragma("unroll") for (int i = 0; i < NKL; ++i) if (tid + 512 * i < NKC) kreg[S][i] = *(const GAS u32x4*)(Kp + (size_t)(t) * 64 * ldk + kgo[i]); \
                         _Pragma("unroll") for (int i = 0; i < NVL; ++i) if (tid + 512 * i < NVC) vreg[S][i] = *(const GAS u32x4*)(Vp + (size_t)(t) * 64 * ldv + vgo[i]); } while (0)
#define ATT_STORE(buf, vslot, S) do { _Pragma("unroll") for (int i = 0; i < NKL; ++i) if (tid + 512 * i < NKC) *(LAS u32x4*)(lds + (buf) * KBUF + klo[i]) = kreg[S][i]; \
                            _Pragma("unroll") for (int i = 0; i < NVL; ++i) if (tid + 512 * i < NVC) *(LAS u32x4*)(lds + (vslot) * VBUF + vlo[i]) = vreg[S][i]; } while (0)
    ATT_LOAD(0, 0);
    bf16x8 qf[DQ / 16];
#pragma unroll
    for (int d = 0; d < DQ / 16; ++d) qf[d] = *(const GAS bf16x8*)(Qp + (size_t)(wave * 32 + r32) * ldq + 16 * d + 8 * hi);
    ATT_STORE(0, 0, 0);
    ATT_LOAD(1, 1);
    __syncthreads();
    float mref = 0.f, lsum = 0.f; f32x16 O[ND], negm;
#pragma unroll
    for (int r = 0; r < 16; ++r) negm[r] = 0.f;
#pragma unroll
    for (int d = 0; d < ND; ++d)
#pragma unroll
        for (int r = 0; r < 16; ++r) O[d][r] = 0.f;
    const int kboff = r32 * KS * 2 + hi * 16;
    const int vboff = 2 * KBUF + ((4 * hi + ((lane & 15) >> 2)) * VS + 16 * ((lane >> 4) & 1) + 4 * (lane & 3)) * 2;
    static_assert((NT - 1) % 3 != 0, "the last tile's V slot must differ from slot 0 (the next unit's prologue writes slot 0 while waves 4-7 finish)");
    const bool grpB = __builtin_amdgcn_readfirstlane(tid >> 6) >= 4;
    int vs_prev = 2, vs_cur = 0, vs_next = 1;
    bf16x8 pf[4];
#define ATT_PV(VSLOT) do { \
        const LAS unsigned char* vb = lds + (VSLOT) * VBUF + vboff; \
        {    \
            bf16x8 vf[2 * ND + 1][2]; \
            __builtin_amdgcn_sched_barrier(0); \
        _Pragma("unroll") \
            for (int s = 0; s < 2; ++s) vf[0][s] = tr2(vb + (16 * s) * VS * 2, vb + (16 * s + 8) * VS * 2); \
        _Pragma("unroll") \
            for (int hb = 0; hb < 2 * ND; ++hb) { \
                if (hb + 1 < 2 * ND) { \
        _Pragma("unroll") \
                    for (int s = 0; s < 2; ++s) vf[hb + 1][s] = tr2(vb + (16 * (2 * ((hb + 1) & 1) + s)) * VS * 2 + ((hb + 1) >> 1) * 64, vb + (16 * (2 * ((hb + 1) & 1) + s) + 8) * VS * 2 + ((hb + 1) >> 1) * 64); \
                } \
                __builtin_amdgcn_sched_barrier(0); \
        _Pragma("unroll") \
                for (int s = 0; s < 2; ++s) O[hb >> 1] = __builtin_amdgcn_mfma_f32_32x32x16_bf16(vf[hb][s], pf[2 * (hb & 1) + s], O[hb >> 1], 0, 0, 0); \
                __builtin_amdgcn_sched_barrier(0); \
            } \
        } \
    } while (0)
#define ATT_ITER(TT, PAR) do { \
        const int cur = (PAR); \
        if ((TT) + 2 < NT) ATT_LOAD((TT) + 2, (PAR)); \
        if (grpB && (TT) > 0) ATT_PV(vs_prev); \
        const LAS unsigned char* kb = lds + cur * KBUF + kboff; \
        f32x16 p0, p1; \
        {    \
             \
            constexpr int HQ = DQ / 32; \
            bf16x8 kfa[HQ], kfb[HQ]; \
        _Pragma("unroll") \
            for (int hq = 0; hq < 2; ++hq) { \
        _Pragma("unroll") \
                for (int d = 0; d < HQ; ++d) { kfa[d] = *(const LAS bf16x8*)(kb + (hq * HQ + d) * 32); kfb[d] = *(const LAS bf16x8*)(kb + 32 * KS * 2 + (hq * HQ + d) * 32); } \
                __builtin_amdgcn_sched_barrier(0); \
        _Pragma("unroll") \
                for (int d = 0; d < HQ; ++d) { \
                    if (hq == 0 && d == 0) { p0 = __builtin_amdgcn_mfma_f32_32x32x16_bf16(kfa[d], qf[d], negm, 0, 0, 0); p1 = __builtin_amdgcn_mfma_f32_32x32x16_bf16(kfb[d], qf[d], negm, 0, 0, 0); } \
                    else { p0 = __builtin_amdgcn_mfma_f32_32x32x16_bf16(kfa[d], qf[hq * HQ + d], p0, 0, 0, 0); p1 = __builtin_amdgcn_mfma_f32_32x32x16_bf16(kfb[d], qf[hq * HQ + d], p1, 0, 0, 0); } \
                } \
                __builtin_amdgcn_sched_barrier(0); \
            } \
        } \
        float mx = fmaxf(fmaxf(p0[0], p1[0]), p0[1]); \
        _Pragma("unroll") \
        for (int r = 1; r < 16; ++r) mx = fmaxf(fmaxf(mx, p1[r]), r + 1 < 16 ? p0[r + 1] : p1[r]); \
        mx = fmaxf(mx, __shfl_xor(mx, 32)); \
        if (__any((TT) == 0 || mx > 8.0f)) {            \
            const float dl = ((TT) == 0) ? mx : fmaxf(mx, 0.f), f = fexp2(-dl); \
            mref += dl; lsum *= f; \
        _Pragma("unroll") \
            for (int r = 0; r < 16; ++r) { p0[r] -= dl; p1[r] -= dl; negm[r] = -mref; } \
        _Pragma("unroll") \
            for (int d = 0; d < ND; ++d) \
        _Pragma("unroll") \
                for (int r = 0; r < 16; ++r) O[d][r] *= f; \
        } \
        float rs = 0.f; \
        _Pragma("unroll") \
        for (int r = 0; r < 16; ++r) { p0[r] = fexp2(p0[r]); p1[r] = fexp2(p1[r]); rs += p0[r] + p1[r]; } \
        lsum += rs; \
        pf[0] = packp(p0, 0); pf[1] = packp(p0, 8); pf[2] = packp(p1, 0); pf[3] = packp(p1, 8); \
        if (!grpB) ATT_PV(vs_cur); \
        if ((TT) + 1 < NT) ATT_STORE((PAR) ^ 1, vs_next, (PAR) ^ 1); \
        __syncthreads(); \
        vs_prev = vs_cur; vs_cur = vs_next; vs_next = (vs_next == 2) ? 0 : vs_next + 1; \
    } while (0)
    for (int t = 0; t < NT; t += 2) { ATT_ITER(t, 0); ATT_ITER(t + 1, 1); }
    if (grpB) ATT_PV(vs_prev);
#undef ATT_ITER
#undef ATT_PV
#undef ATT_LOAD
#undef ATT_STORE
    const float l = lsum + __shfl_xor(lsum, 32), inv = 1.f / l;
    bf16_t* orow = Op + (size_t)(wave * 32 + r32) * ldo + 4 * hi;
    if (MODE == 0) {
#pragma unroll
        for (int d = 0; d < ND; ++d)
#pragma unroll
            for (int g = 0; g < 4; ++g) { u32x2v w; w.x = cvt_pk(O[d][4 * g] * inv, O[d][4 * g + 1] * inv); w.y = cvt_pk(O[d][4 * g + 2] * inv, O[d][4 * g + 3] * inv); *(GAS u32x2v*)(orow + 32 * d + 8 * g) = w; }
    } else {
        const bf16_t* o0row = O0p + (size_t)(wave * 32 + r32) * ldo0 + 4 * hi;
        const float li = lam * inv; float ss = 0.f;
#pragma unroll
        for (int d = 0; d < ND; ++d)
#pragma unroll
            for (int g = 0; g < 4; ++g) { const u32x2v w = *(const GAS u32x2v*)(o0row + 32 * d + 8 * g);
                const float a0 = bf_lo(w.x) - li * O[d][4 * g], a1 = bf_hi(w.x) - li * O[d][4 * g + 1], a2 = bf_lo(w.y) - li * O[d][4 * g + 2], a3 = bf_hi(w.y) - li * O[d][4 * g + 3];
                O[d][4 * g] = a0; O[d][4 * g + 1] = a1; O[d][4 * g + 2] = a2; O[d][4 * g + 3] = a3; ss += (a0 * a0 + a1 * a1) + (a2 * a2 + a3 * a3); }
        ss += __shfl_xor(ss, 32);
        const float rn = (1.0f - LAMBDA_INIT) / sqrtf(ss * (1.f / (float)DV) + 1e-5f);
#pragma unroll
        for (int d = 0; d < ND; ++d)
#pragma unroll
            for (int g = 0; g < 4; ++g) { const f32x4 gs = *(const GAS f32x4*)(gsub + 32 * d + 8 * g + 4 * hi);
                u32x2v w; w.x = cvt_pk(O[d][4 * g] * rn * gs[0], O[d][4 * g + 1] * rn * gs[1]); w.y = cvt_pk(O[d][4 * g + 2] * rn * gs[2], O[d][4 * g + 3] * rn * gs[3]); *(GAS u32x2v*)(orow + 32 * d + 8 * g) = w; }
    }
}
__device__ __forceinline__ void attn_dilated_unit(LAS unsigned char* wl, const bf16_t* __restrict__ QA, const bf16_t* __restrict__ KA, const bf16_t* __restrict__ VA,
                                                  bf16_t* __restrict__ OAp, float* __restrict__ LSEp, int b, int h, int shift, int r, int lb, int lane) {
    constexpr int VS = 96;
    const int r32 = lane & 31, hi = lane >> 5, L = SEQ >> shift, l0 = lb * 32;
    const size_t rowb = (size_t)b * SEQ;
    const int tq = ((l0 + r32) << shift) + r;
    bf16x8 qf[4];
#pragma unroll
    for (int d = 0; d < 4; ++d) qf[d] = *(const GAS bf16x8*)(QA + (rowb + tq) * 512 + h * 64 + 16 * d + 8 * hi);
    float m = NEG_BIG, lsum = 0.f; f32x16 O[2];
#pragma unroll
    for (int d = 0; d < 2; ++d)
#pragma unroll
        for (int q = 0; q < 16; ++q) O[d][q] = 0.f;
    const int vboff = ((4 * hi + ((lane & 15) >> 2)) * VS + 16 * ((lane >> 4) & 1) + 4 * (lane & 3)) * 2;
    for (int j = 0; j < 5; ++j) {
        const int kl0 = l0 - 64 + 32 * j;
        if (kl0 + 31 < 0 || kl0 >= L) continue;
        int kl = kl0 + r32; kl = kl < 0 ? 0 : (kl > L - 1 ? L - 1 : kl);
        const bf16_t* kp = KA + (rowb + (size_t)((kl << shift) + r)) * 512 + h * 64 + 8 * hi;
        bf16x8 kf[4];
#pragma unroll
        for (int d = 0; d < 4; ++d) kf[d] = *(const GAS bf16x8*)(kp + 16 * d);
        u32x4 vreg[4];
#pragma unroll
        for (int i = 0; i < 4; ++i) { const int id = lane + 64 * i, vrow = id >> 3, ch = id & 7; int kv = kl0 + vrow; kv = kv < 0 ? 0 : (kv > L - 1 ? L - 1 : kv);
            vreg[i] = *(const GAS u32x4*)(VA + (rowb + (size_t)((kv << shift) + r)) * 512 + h * 64 + ch * 8); }
        f32x16 p0;
#pragma unroll
        for (int q = 0; q < 16; ++q) p0[q] = 0.f;
#pragma unroll
        for (int d = 0; d < 4; ++d) p0 = __builtin_amdgcn_mfma_f32_32x32x16_bf16(kf[d], qf[d], p0, 0, 0, 0);
        const int ql = l0 + r32;
#pragma unroll
        for (int q = 0; q < 16; ++q) { const int klr = kl0 + (q & 3) + 8 * (q >> 2) + 4 * hi, df = klr - ql; const bool ok = klr >= 0 && klr < L && df <= 64 && df >= -64; p0[q] = ok ? p0[q] : -INFINITY; }
        float mx = p0[0];
#pragma unroll
        for (int q = 1; q < 16; ++q) mx = fmaxf(mx, p0[q]);
        mx = fmaxf(mx, __shfl_xor(mx, 32));
        const float mn = fmaxf(m, mx), al = fexp2(m - mn); m = mn;
        float rs = 0.f;
#pragma unroll
        for (int q = 0; q < 16; ++q) { p0[q] = fexp2(p0[q] - mn); rs += p0[q]; }
        lsum = lsum * al + rs;
#pragma unroll
        for (int d = 0; d < 2; ++d)
#pragma unroll
            for (int q = 0; q < 16; ++q) O[d][q] *= al;
        bf16x8 pf[2]; pf[0] = packp(p0, 0); pf[1] = packp(p0, 8);
#pragma unroll
        for (int i = 0; i < 4; ++i) { const int id = lane + 64 * i; *(LAS u32x4*)(wl + (id >> 3) * VS * 2 + (id & 7) * 16) = vreg[i]; }
        const LAS unsigned char* vb = wl + vboff;
#pragma unroll
        for (int d = 0; d < 2; ++d)
#pragma unroll
            for (int s = 0; s < 2; ++s) {
                const bf16x8 vf = tr2(vb + (16 * s) * VS * 2 + d * 64, vb + (16 * s + 8) * VS * 2 + d * 64);
                O[d] = __builtin_amdgcn_mfma_f32_32x32x16_bf16(vf, pf[s], O[d], 0, 0, 0);
            }
    }
    const float l = lsum + __shfl_xor(lsum, 32), inv = 1.f / l;
    bf16_t* orow = OAp + (rowb + tq) * 512 + h * 64 + 4 * hi;
#pragma unroll
    for (int d = 0; d < 2; ++d)
#pragma unroll
        for (int g = 0; g < 4; ++g) { u32x2v w; w.x = cvt_pk(O[d][4 * g] * inv, O[d][4 * g + 1] * inv); w.y = cvt_pk(O[d][4 * g + 2] * inv, O[d][4 * g + 3] * inv); *(GAS u32x2v*)(orow + 32 * d + 8 * g) = w; }
    if (hi == 0) LSEp[(rowb + tq) * 8 + h] = m + __log2f(l);
}

struct Args {
    const float* x; const float* p; const int* pos;
    const float *ab_w_in, *ab_q_norm, *ab_w_q_up, *ab_kv_norm, *ab_w_kv_up, *ab_w_out;
    const float *c_w_qkv, *c_lambda, *c_subln, *c_w_out;
    const float *ln_mix_g, *ln_mix_b, *ffn_w_gate, *ffn_w_up, *ffn_conv_w, *ffn_conv_b, *ffn_w_down, *ln_ffn_g, *ln_ffn_b, *ple_w_gate, *ple_w_proj;
    float* out; unsigned char* ws;
};

#ifndef PHM
#define PHM 0xFFFFFFFF
#endif
#ifndef DBL
#define DBL 0
#endif
#define PH(k) if ((PHM >> (k)) & 1) for (int rep_ = 0; rep_ < (((DBL >> (k)) & 1) ? 2 : 1); ++rep_)
#define FRESH() int tid = threadIdx.x; asm volatile("" : "+v"(tid)); const int lane = tid & 63, wave = __builtin_amdgcn_readfirstlane(tid >> 6); \
    unsigned char* ws0_ = a.ws; asm volatile("" : "+s"(ws0_)); unsigned char* ws = (unsigned char*)(__attribute__((address_space(1))) unsigned char*)ws0_; \
    float* xf0_ = a.out; asm volatile("" : "+s"(xf0_)); float* XF = (float*)(__attribute__((address_space(1))) float*)xf0_; \
    const int G = gridDim.x, bx = blockIdx.x, vcu = (G % 8 == 0) ? (bx % 8) * (G / 8) + bx / 8 : bx, gw = vcu * 8 + wave, NGW = G * 8; \
    (void)lane; (void)gw; (void)NGW; (void)XF; (void)ws
#define WSP(T, off) ((T*)(ws + (off)))
#ifndef ZERO_IN_KERNEL
#define ZERO_IN_KERNEL 1
#endif
#ifndef TPM
#define TPM 0
#endif
#define TB(k) do { if ((TPM >> (k)) & 1) tp_t0 = __builtin_amdgcn_s_memrealtime(); } while (0)
#define TE(k) do { if ((TPM >> (k)) & 1) tp_acc += __builtin_amdgcn_s_memrealtime() - tp_t0; } while (0)
__global__ void __launch_bounds__(512) fwd_megakernel(Args a) {
    extern __shared__ __attribute__((aligned(16))) unsigned char lds_raw[];
    LAS unsigned char* lds = (LAS unsigned char*)lds_raw;
    cg::grid_group grid = cg::this_grid();
    unsigned long long tp_t0 = 0, tp_acc = 0; (void)tp_t0;
    volatile LAS unsigned* bst = (volatile LAS unsigned*)(lds + 131072);
    if (threadIdx.x < 2) bst[threadIdx.x] = 0u;
#if ZERO_IN_KERNEL
    if (blockIdx.x == 0) { unsigned* bw = (unsigned*)a.ws; for (int i = threadIdx.x; i < 4096; i += 512) __hip_atomic_store(bw + i, 0u, __ATOMIC_RELAXED, __HIP_MEMORY_SCOPE_AGENT); }
    __syncthreads();
    XcdBarrier bar; bar.bar = (unsigned*)a.ws; bar.x = 0; bar.st = bst;
#else
    __syncthreads();
    XcdBarrier bar = xcd_barrier_post((unsigned*)a.ws, bst);
#endif
#define GSYNC() xcd_barrier(bar)

        TB(0);
    PH(0) {
        FRESH();
        const int gt = bx * 512 + tid, NTH = G * 512;
        LAS float* scr = (LAS float*)(lds + wave * 16384);
        TB(20);
        {
#define WITEM(cnt, ...) if (r < (cnt)) { prep_item(__VA_ARGS__); continue; } r -= (cnt);
            float* part = WSP(float, WS_PART);
            for (int it = gw; it < 13712; it += NGW) {
                int r = it;
                WITEM(1152, a.ab_w_in, 1024, 2208, WSP(bf16_t, WS_W_IN), 2304, MapWin{}, scr, r, lane)
                WITEM(1536, a.c_w_qkv, 1024, 3072, WSP(bf16_t, WS_W_CQKV), 3072, MapRope64{2048}, scr, r, lane)
                WITEM(144, a.ab_w_q_up, 384, 768, WSP(bf16_t, WS_W_QUP), 768, MapQup{}, scr, r, lane)
                WITEM(128, a.ab_w_kv_up, 256, 1024, WSP(bf16_t, WS_W_KVUP), 1024, MapKvup{}, scr, r, lane)
                WITEM(512, a.ab_w_out, 1024, 1024, WSP(bf16_t, WS_W_OUT0), 1024, MapId{}, scr, r, lane)
                WITEM(512, a.c_w_out, 1024, 1024, WSP(bf16_t, WS_W_OUT1), 1024, MapId{}, scr, r, lane)
                const int l = r >= 4864 ? 1 : 0; r -= l * 4864;
                float* pl = part + (size_t)l * 16 * VEC_L;
                WITEM(1408, a.ffn_w_gate + (size_t)l * 1024 * DFF, 1024, DFF, WSP(bf16_t, WS_W_GATE) + (size_t)l * 2 * DFF * 1024, DFF, MapId{}, scr, r, lane, a.ln_mix_g + l * DM, a.ln_mix_b + l * DM, pl + V_CSG, pl + V_BWG, 1)
                WITEM(1408, a.ffn_w_up + (size_t)l * 1024 * DFF, 1024, DFF, WSP(bf16_t, WS_W_GATE) + (size_t)l * 2 * DFF * 1024, DFF, MapId{}, scr, r, lane, a.ln_mix_g + l * DM, a.ln_mix_b + l * DM, pl + V_CSU, pl + V_BWU, 2)
                WITEM(1408, a.ffn_w_down + (size_t)l * DFF * 1024, DFF, 1024, WSP(bf16_t, WS_W_DOWN) + (size_t)l * 1024 * DFF, 1024, MapId{}, scr, r, lane)
                WITEM(512, a.ple_w_gate + (size_t)l * 1024 * 1024, 1024, 1024, WSP(bf16_t, WS_W_PG) + (size_t)l * 1024 * 1024, 1024, MapId{}, scr, r, lane, a.ln_ffn_g + l * DM, a.ln_ffn_b + l * DM, pl + V_CSP, pl + V_BWP)
                prep_item(a.ple_w_proj + (size_t)l * 256 * 1024, 256, 1024, WSP(bf16_t, WS_W_PP) + (size_t)l * 1024 * 256, 1024, MapId{}, scr, r, lane);
            }
#undef WITEM
        }
        TE(20); TB(21);
        { GAS f32x4* st4 = (GAS f32x4*)WSP(f32x4, WS_ST); for (int i = gt; i < 4 * M * 2 / 4; i += NTH) st4[i] = (f32x4){0.f, 0.f, 0.f, 0.f}; }
        TE(21); TB(22);
        float* ropeA = WSP(float, WS_ROPEA); float* ropeB = WSP(float, WS_ROPEB);
        {
            LAS float* invf = (LAS float*)(lds + 7 * 16384 + 12288);
            __syncthreads();
            if (tid < 24) invf[tid] = tid < 8 ? 1.0f / powf(500000.0f, (float)tid * 0.125f) : 1.0f / powf(500000.0f, (float)(tid - 8) * 0.0625f);
            __syncthreads();
            for (int idx = gt; idx < M * 24; idx += NTH) {
                const int row = idx / 24, j = idx % 24; const float ang = (float)a.pos[row] * invf[j];
                float sn, cs; sincosf(ang, &sn, &cs);
                float* dst = j < 8 ? ropeA + (size_t)row * 16 + 2 * j : ropeB + (size_t)row * 32 + 2 * (j - 8);
                *(GAS f32x2v*)dst = (f32x2v){cs, sn};
            }
        }
        TE(22); TB(23);
        GAS u32x4* XB4 = (GAS u32x4*)WSP(u32x4, WS_XB); GAS u32x4* PB4 = (GAS u32x4*)WSP(u32x4, WS_PB);
#define CVT_LOOP(SRC, DST, COUNT) do { int i_ = gt; \
            for (; i_ + 3 * NTH < (COUNT); i_ += 4 * NTH) { f32x4 v_[8]; _Pragma("unroll") for (int j_ = 0; j_ < 4; ++j_) { v_[2 * j_] = ((const f32x4*)(SRC))[2 * (i_ + j_ * NTH)]; v_[2 * j_ + 1] = ((const f32x4*)(SRC))[2 * (i_ + j_ * NTH) + 1]; } \
                _Pragma("unroll") for (int j_ = 0; j_ < 4; ++j_) (DST)[i_ + j_ * NTH] = pack8(v_[2 * j_], v_[2 * j_ + 1]); } \
            for (; i_ < (COUNT); i_ += NTH) { const f32x4 v0_ = ((const f32x4*)(SRC))[2 * i_], v1_ = ((const f32x4*)(SRC))[2 * i_ + 1]; (DST)[i_] = pack8(v0_, v1_); } } while (0)
        CVT_LOOP(a.x, XB4, M * DM / 8);
        (void)PB4;
        TE(23);
    }
#if ZERO_IN_KERNEL
    grid.sync();
    bar = xcd_barrier_post((unsigned*)a.ws, bst);
#else
    if (a.ws == nullptr) grid.sync(); else GSYNC();
#endif
        TE(0);

    for (int layer = 0; layer < 2; ++layer) {
        if (layer == 0) {
        TB(1);
            PH(1) { FRESH();
                    {
                        const float* part = WSP(float, WS_PART); float* vec = WSP(float, WS_VEC);
                        for (int idx = bx * 512 + tid; idx < 2 * VEC_L; idx += G * 512) { const int l = idx / VEC_L, v = idx % VEC_L; float s = 0.f;
#pragma unroll
                            for (int kb = 0; kb < 16; ++kb) s += part[((size_t)l * 16 + kb) * VEC_L + v];
                            vec[idx] = s; }
                    }
                    run_gemm(lds, WSP(bf16_t, WS_XB), WSP(bf16_t, WS_W_IN), 2304, 1024, G,
                        FWin{WSP(bf16_t, WS_QA), WSP(bf16_t, WS_KA), WSP(bf16_t, WS_VA), WSP(float, WS_LAT), WSP(bf16_t, WS_KB), WSP(float, WS_ROPEA), WSP(float, WS_ROPEB)}); }
            GSYNC();
        TE(1);
        TB(2);
            PH(2) { FRESH(); unsigned char* dos = (unsigned char*)XF; latnorm_phase(WSP(float, WS_LAT), (bf16_t*)(dos + DO_CQN), (bf16_t*)(dos + DO_CKVN), a.ab_q_norm, a.ab_kv_norm, gw, NGW, lane); }
            GSYNC();
        TE(2);
        TB(3);
            PH(3) { FRESH(); unsigned char* dos = (unsigned char*)XF; run_gemm(lds, (bf16_t*)(dos + DO_CQN), WSP(bf16_t, WS_W_QUP), 768, 384, G, FQup{(bf16_t*)(dos + DO_QB), WSP(float, WS_ROPEB)}); }
            PH(4) { FRESH(); unsigned char* dos = (unsigned char*)XF; run_gemm(lds, (bf16_t*)(dos + DO_CKVN), WSP(bf16_t, WS_W_KVUP), 1024, 256, G, FKvup{WSP(bf16_t, WS_KB), (bf16_t*)(dos + DO_VB)}); }
            GSYNC();
        TE(3);
        TB(5);
            PH(5) {
                FRESH(); unsigned char* dos = (unsigned char*)XF;
                const bf16_t* QB = (const bf16_t*)(dos + DO_QB); const bf16_t* VB = (const bf16_t*)(dos + DO_VB); const bf16_t* KB = WSP(bf16_t, WS_KB); bf16_t* MIX = WSP(bf16_t, WS_MIX);
                constexpr int NU = BATCH * 8 * 8; const int upc = (NU + G - 1) / G;
                for (int u = vcu * upc; u < NU && u < (vcu + 1) * upc; ++u) {
                    const int ui = u - vcu * upc; const int bh = (upc == 4 && G % 8 == 0) ? (vcu >> 3) * 4 + ui : u >> 3, qb = (upc == 4 && G % 8 == 0) ? (vcu & 7) : u & 7, b = bh >> 3, h = bh & 7;
                    attn_dense_unit<96, 64, 0>(lds, QB + ((size_t)b * SEQ + qb * 256) * 768 + h * 96, 768, KB + (size_t)b * SEQ * 768 + h * 96, 768,
                                            VB + (size_t)b * SEQ * 512 + h * 64, 512, MIX + ((size_t)b * SEQ + qb * 256) * 1024 + 512 + h * 64, 1024, tid);
                }
            }
            PH(6) {
                FRESH();
                constexpr int NDU = BATCH * 8 * 3 * 64;
                LAS unsigned char* wl = lds + wave * 8192;
                for (int u = gw; u < NDU; u += NGW) {
                    const int lbr = u & 63, rest = u >> 6, pt = rest % 3, bh = rest / 3, b = bh >> 3, h = bh & 7, shift = 2 * pt;
                    const int r = lbr >> (6 - shift), lb = lbr & ((64 >> shift) - 1);
                    attn_dilated_unit(wl, WSP(bf16_t, WS_QA), WSP(bf16_t, WS_KA), WSP(bf16_t, WS_VA), WSP(bf16_t, WS_OA) + (size_t)pt * M * 512, WSP(float, WS_LSE) + (size_t)pt * M * 8, b, h, shift, r, lb, lane);
                }
                { const int gt = bx * 512 + tid, NTH = G * 512; GAS u32x4* PBc = (GAS u32x4*)WSP(u32x4, WS_PB); CVT_LOOP(a.p, PBc, 2 * M * 256 / 8); }
#undef CVT_LOOP
            }
            GSYNC();
        TE(5);
        TB(7);
            PH(7) { FRESH(); merge_phase(WSP(bf16_t, WS_OA), WSP(float, WS_LSE), WSP(bf16_t, WS_MIX), gw, NGW, lane); }
            GSYNC();
        TE(7);
        TB(8);
            PH(8) { FRESH(); run_gemm_e(lds, WSP(bf16_t, WS_MIX), WSP(bf16_t, WS_W_OUT0), 1024, 1024, G, EpiResidStat<false>{a.x, nullptr, nullptr, nullptr, WSP(bf16_t, WS_XB), WSP(float, WS_ST)}); }
            GSYNC();
        TE(8);
        } else {
        TB(9);
            PH(9) { FRESH(); run_gemm(lds, (const bf16_t*)XF, WSP(bf16_t, WS_W_CQKV), 3072, 1024, G, FCqkv{WSP(bf16_t, WS_QC), WSP(bf16_t, WS_KC), WSP(bf16_t, WS_VC), WSP(float, WS_ROPEA)}); }
            GSYNC();
        TE(9);
        TB(10);
            PH(10) {
                FRESH();
                const bf16_t* QC = WSP(bf16_t, WS_QC); const bf16_t* KC = WSP(bf16_t, WS_KC); const bf16_t* VC = WSP(bf16_t, WS_VC); bf16_t* O0 = WSP(bf16_t, WS_O0); bf16_t* MIX1 = WSP(bf16_t, WS_MIX1);
                const float s01 = wave_sum(a.c_lambda[lane] * a.c_lambda[64 + lane]), s23 = wave_sum(a.c_lambda[128 + lane] * a.c_lambda[192 + lane]);
                const float lam = expf(s01) - expf(s23) + LAMBDA_INIT;
                constexpr int NU = BATCH * 8 * 8 * 2; int upc = (NU + G - 1) / G; upc += upc & 1;
                for (int u = vcu * upc; u < NU && u < (vcu + 1) * upc; ++u) {
                    const int ui = u - vcu * upc; const bool grp = (upc == 8 && G % 8 == 0);
                    const int c = u & 1, qb = grp ? (vcu & 7) : (u >> 1) & 7, bh = grp ? (vcu >> 3) * 4 + (ui >> 1) : u >> 4, b = bh >> 3, h = bh & 7, hh = 2 * h + c;
                    const size_t qrow = (size_t)b * SEQ + qb * 256;
                    if (c == 0) attn_dense_unit<64, 128, 0>(lds, QC + qrow * 1024 + hh * 64, 1024, KC + (size_t)b * SEQ * 1024 + hh * 64, 1024, VC + (size_t)b * SEQ * 1024 + h * 128, 1024,
                                                            O0 + qrow * 1024 + h * 128, 1024, tid);
                    else attn_dense_unit<64, 128, 1>(lds, QC + qrow * 1024 + hh * 64, 1024, KC + (size_t)b * SEQ * 1024 + hh * 64, 1024, VC + (size_t)b * SEQ * 1024 + h * 128, 1024,
                                                     MIX1 + qrow * 1024 + h * 128, 1024, tid, O0 + qrow * 1024 + h * 128, 1024, lam, a.c_subln);
                }
            }
            GSYNC();
        TE(10);
        TB(12);
            PH(12) { FRESH(); run_gemm_e(lds, WSP(bf16_t, WS_MIX1), WSP(bf16_t, WS_W_OUT1), 1024, 1024, G, EpiResidStat<false>{nullptr, nullptr, nullptr, nullptr, WSP(bf16_t, WS_XB), WSP(float, WS_ST) + (size_t)2 * M * 2, (const bf16_t*)XF}); }
            GSYNC();
        TE(12);
        }
        TB(14);
        PH(14) { FRESH(); run_gemm_e(lds, WSP(bf16_t, WS_XB), WSP(bf16_t, WS_W_GATE) + (size_t)layer * 2 * DFF * 1024, 2 * DFF, 1024, G,
                     EpiGateUp{WSP(bf16_t, WS_FG), WSP(bf16_t, WS_BA), WSP(bf16_t, WS_BU), WSP(float, WS_BC), a.ffn_conv_w + (size_t)layer * 3 * DFF, a.ffn_conv_b + (size_t)layer * DFF,
                               WSP(float, WS_ST) + (size_t)(2 * layer) * M * 2, WSP(float, WS_VEC) + layer * VEC_L}); }
        GSYNC();
        TE(14);
        TB(15);
        PH(15) { FRESH(); ffn_fixup_phase(WSP(bf16_t, WS_FG), WSP(bf16_t, WS_BA), WSP(bf16_t, WS_BU), WSP(float, WS_BC), a.ffn_conv_w + (size_t)layer * 3 * DFF, bx * 512 + tid, G * 512); }
        GSYNC();
        TE(15);
        TB(16);
        PH(16) { FRESH(); run_gemm_e(lds, WSP(bf16_t, WS_FG), WSP(bf16_t, WS_W_DOWN) + (size_t)layer * 1024 * DFF, 1024, DFF, G,
                     EpiResidStat<true>{nullptr, WSP(float, WS_ST) + (size_t)(2 * layer) * M * 2, a.ln_mix_g + layer * DM, a.ln_mix_b + layer * DM, WSP(bf16_t, WS_XB), WSP(float, WS_ST) + (size_t)(2 * layer + 1) * M * 2}); }
        PH(17) { FRESH(); run_gemm(lds, WSP(bf16_t, WS_PB) + (size_t)layer * M * 256, WSP(bf16_t, WS_W_PP) + (size_t)layer * 1024 * 256, 1024, 256, G, FBf16{WSP(bf16_t, WS_PJ), 1024}); }
        GSYNC();
        TE(16);
        TB(19);
        PH(19) { FRESH(); run_gemm(lds, WSP(bf16_t, WS_XB), WSP(bf16_t, WS_W_PG) + (size_t)layer * 1024 * 1024, 1024, 1024, G, FPle{layer == 0 ? (float*)nullptr : XF, WSP(bf16_t, WS_XB), WSP(bf16_t, WS_PJ), layer == 0 ? (bf16_t*)XF : (bf16_t*)nullptr,     WSP(float, WS_ST) + (size_t)(2 * layer + 1) * M * 2,
                         WSP(float, WS_VEC) + layer * VEC_L + V_CSP, WSP(float, WS_VEC) + layer * VEC_L + V_BWP, a.ln_ffn_g + layer * DM, a.ln_ffn_b + layer * DM}); }
        GSYNC();
        TE(19);
    }
    if (TPM) { const unsigned long long t1 = __builtin_amdgcn_s_memrealtime(); while (__builtin_amdgcn_s_memrealtime() - t1 < tp_acc) __builtin_amdgcn_s_sleep(8); }
}

extern "C" void kernel_launch(void* const* d_in, const int* in_sizes, int n_in, void* d_out, int out_size, void* d_ws, size_t ws_size, hipStream_t stream) {
    static int grid = 0;
    if (grid == 0) {
        if (n_in != 24 || out_size != M * DM || ws_size < WS_NEED) { fprintf(stderr, "kernel_launch: unexpected shapes (n_in %d out %d ws %zu)\n", n_in, out_size, ws_size); grid = -1; return; }
        int dev = 0, cus = 0, per_cu = 0;
        hipGetDevice(&dev); hipDeviceGetAttribute(&cus, hipDeviceAttributeMultiprocessorCount, dev);
        hipFuncSetAttribute((const void*)fwd_megakernel, hipFuncAttributeMaxDynamicSharedMemorySize, LDS_BYTES);
        hipOccupancyMaxActiveBlocksPerMultiprocessor(&per_cu, (const void*)fwd_megakernel, 512, LDS_BYTES);
        if (per_cu < 1) { fprintf(stderr, "kernel_launch: occupancy query says %d blocks per CU\n", per_cu); per_cu = 1; }
        grid = cus;
        (void)hipGetLastError();
    }
    if (grid < 0) return;
    if (!ZERO_IN_KERNEL && hipMemsetAsync(d_ws, 0, 16384, stream) != hipSuccess) { fprintf(stderr, "kernel_launch: memset of the barrier words failed\n"); return; }
    Args a{};
    a.x = (const float*)d_in[0]; a.p = (const float*)d_in[1]; a.pos = (const int*)d_in[2];
    a.ab_w_in = (const float*)d_in[3]; a.ab_q_norm = (const float*)d_in[4]; a.ab_w_q_up = (const float*)d_in[5]; a.ab_kv_norm = (const float*)d_in[6];
    a.ab_w_kv_up = (const float*)d_in[7]; a.ab_w_out = (const float*)d_in[8]; a.c_w_qkv = (const float*)d_in[9]; a.c_lambda = (const float*)d_in[10];
    a.c_subln = (const float*)d_in[11]; a.c_w_out = (const float*)d_in[12]; a.ln_mix_g = (const float*)d_in[13]; a.ln_mix_b = (const float*)d_in[14];
    a.ffn_w_gate = (const float*)d_in[15]; a.ffn_w_up = (const float*)d_in[16]; a.ffn_conv_w = (const float*)d_in[17]; a.ffn_conv_b = (const float*)d_in[18];
    a.ffn_w_down = (const float*)d_in[19]; a.ln_ffn_g = (const float*)d_in[20]; a.ln_ffn_b = (const float*)d_in[21]; a.ple_w_gate = (const float*)d_in[22]; a.ple_w_proj = (const float*)d_in[23];
    a.out = (float*)d_out; a.ws = (unsigned char*)d_ws;
    void* args[] = {&a};
    hipError_t e = hipLaunchCooperativeKernel((const void*)fwd_megakernel, dim3(grid), dim3(512), args, LDS_BYTES, stream);
    if (e != hipSuccess) fprintf(stderr, "kernel_launch: cooperative launch failed: %s (grid %d)\n", hipGetErrorString(e), grid);
}
```
